# Optimizing an MI355X kernel written in HIP

```python
import jax, jax.numpy as jnp
from jax import lax
import numpy as np

D_MODEL = 2048
BATCH = 2
SEQ = 16384
DEPTH = 2

GRID_W = 64
CTX_LEN = 256
N_EVEN = (DEPTH + 1) // 2
N_ODD = DEPTH // 2
EPS = 1e-6
ROPE_BASE = 10000.0

GLA_HEADS = 4
GLA_DK = 128
GLA_DV = 256
GLA_GATE_RANK = 16
GLA_GATE_NORM = 16.0
GLA_CHUNK = 64

MLA_HEADS = 8
MLA_Q_RANK = 768
MLA_KV_RANK = 512
MLA_NOPE = 128
MLA_ROPE = 64
MLA_DV = 128
MLA_QBLOCK = 128
MLA_SCALE = (MLA_NOPE + MLA_ROPE) ** -0.5

RET_HEADS = 8
RET_DK = 256
RET_DV = 256
RET_CHUNK = 128

D_FF = 5632
N_EXPERTS = 8
TOP_K = 2

EVEN_SIZES = (GLA_HEADS * GLA_DK, GLA_HEADS * GLA_DK, GLA_HEADS * GLA_DV, GLA_HEADS * GLA_DV,
              GLA_GATE_RANK, GLA_GATE_RANK, MLA_Q_RANK, MLA_KV_RANK, MLA_ROPE)
EVEN_IN = sum(EVEN_SIZES)
EVEN_MIX = GLA_HEADS * GLA_DV + MLA_HEADS * MLA_DV
ODD_SIZES = (RET_HEADS * RET_DK, RET_HEADS * RET_DK, RET_HEADS * RET_DV, RET_HEADS * RET_DV)
ODD_IN = sum(ODD_SIZES)
ODD_MIX = RET_HEADS * RET_DV

kernel_name = "hybrid_gla_mla_retention_moe_dit_block"

F32 = jnp.float32


def _split(a, sizes):
    out, start = [], 0
    for s in sizes:
        out.append(a[..., start:start + s])
        start += s
    return out


def heads(a, n_heads):
    B, T, _ = a.shape
    return a.reshape(B, T, n_heads, -1).transpose(0, 2, 1, 3)


def merge_heads(a):
    B, H, T, d = a.shape
    return a.transpose(0, 2, 1, 3).reshape(B, T, H * d)


def rev(a):
    return jnp.flip(a, axis=2)


def rmsnorm(x, g):
    x32 = x.astype(F32)
    y = x32 * lax.rsqrt(jnp.mean(x32 * x32, axis=-1, keepdims=True) + EPS)
    return (y * g.astype(F32)).astype(x.dtype)


def head_rmsnorm(o, g):
    return o * lax.rsqrt(jnp.mean(o * o, axis=-1, keepdims=True) + EPS) * g.astype(F32)


def head_groupnorm(o, g):
    mu = jnp.mean(o, axis=-1, keepdims=True)
    d = o - mu
    return d * lax.rsqrt(jnp.mean(d * d, axis=-1, keepdims=True) + EPS) * g.astype(F32)


def axial_rope(rows, dim):
    row = jnp.repeat(jnp.arange(rows, dtype=F32), GRID_W)
    col = jnp.tile(jnp.arange(GRID_W, dtype=F32), rows)
    half = dim // 2
    inv = 1.0 / (ROPE_BASE ** (jnp.arange(0, half, 2, dtype=F32) / half))
    ang = jnp.concatenate([row[:, None] * inv, col[:, None] * inv], axis=-1)
    return jnp.cos(ang), jnp.sin(ang)


def apply_rope(x, cos, sin):
    xp = x.reshape(x.shape[:-1] + (x.shape[-1] // 2, 2)).astype(F32)
    x0, x1 = xp[..., 0], xp[..., 1]
    out = jnp.stack([x0 * cos - x1 * sin, x0 * sin + x1 * cos], axis=-1)
    return out.reshape(x.shape).astype(x.dtype)


def gla_chunk_scan(q, k, v, log_a, s0):
    B, H, T, dk = q.shape
    dv = v.shape[-1]
    n = T // GLA_CHUNK

    def to_chunks(a):
        return jnp.moveaxis(a.reshape(B, H, n, GLA_CHUNK, a.shape[-1]), 2, 0)

    lower = jnp.tril(jnp.ones((GLA_CHUNK, GLA_CHUNK), dtype=bool))

    def step(S, inp):
        qc, kc, vc, ac = inp
        b = jnp.cumsum(ac, axis=-2)
        b_last = b[..., -1:, :]
        qe = qc * jnp.exp(b)
        att = jnp.einsum('bhid,bhjd->bhij', qe, kc * jnp.exp(-b))
        att = jnp.where(lower, att, 0.0)
        o = jnp.einsum('bhij,bhjv->bhiv', att, vc) + jnp.einsum('bhid,bhdv->bhiv', qe, S)
        S = (jnp.swapaxes(jnp.exp(b_last), -1, -2) * S
             + jnp.einsum('bhjd,bhjv->bhdv', kc * jnp.exp(b_last - b), vc))
        return S, o

    S, o = lax.scan(step, s0, (to_chunks(q), to_chunks(k), to_chunks(v), to_chunks(log_a)))
    return jnp.moveaxis(o, 0, 2).reshape(B, H, T, dv), S


def retention_chunk_scan(q, k, v, log_gamma, s0):
    B, H, T, dk = q.shape
    dv = v.shape[-1]
    n = T // RET_CHUNK
    pos = jnp.arange(RET_CHUNK, dtype=F32)
    diff = pos[:, None] - pos[None, :]
    decay = jnp.where(diff >= 0, jnp.exp(log_gamma[:, None, None] * jnp.maximum(diff, 0.0)), 0.0)
    q_dec = jnp.exp(log_gamma[:, None] * (pos + 1.0))[..., None]
    k_dec = jnp.exp(log_gamma[:, None] * (RET_CHUNK - 1.0 - pos))[..., None]
    c_dec = jnp.exp(log_gamma * RET_CHUNK)[:, None, None]

    def to_chunks(a):
        return jnp.moveaxis(a.reshape(B, H, n, RET_CHUNK, a.shape[-1]), 2, 0)

    def step(S, inp):
        qc, kc, vc = inp
        att = jnp.einsum('bhid,bhjd->bhij', qc, kc) * decay
        o = jnp.einsum('bhij,bhjv->bhiv', att, vc) + jnp.einsum('bhid,bhdv->bhiv', qc * q_dec, S)
        S = c_dec * S + jnp.einsum('bhjd,bhjv->bhdv', kc * k_dec, vc)
        return S, o

    S, o = lax.scan(step, s0, (to_chunks(q), to_chunks(k), to_chunks(v)))
    return jnp.moveaxis(o, 0, 2).reshape(B, H, T, dv), S


def mla_attend(qn, qr, kn, kr, v):
    s = jnp.einsum('bhqd,bhkd->bhqk', qn, kn) + jnp.einsum('bhqr,bkr->bhqk', qr, kr)
    p = jax.nn.softmax(s.astype(F32) * MLA_SCALE, axis=-1)
    return jnp.einsum('bhqk,bhkv->bhqv', p.astype(v.dtype), v)


def even_mixer(h, hc, cos, sin, w_in, w_g2, b_g2, gla_g, q_norm, w_uq, kv_norm, w_ukv, w_out, need_ctx):
    B, T, _ = h.shape
    gq, gk, gv, gr, gaf, gab, mq, mkv, mkr = _split(h @ w_in, EVEN_SIZES)
    cgq, cgk, cgv, cgr, cgaf, cgab, cmq, cmkv, cmkr = _split(hc @ w_in, EVEN_SIZES)

    def gla_prep(q, k, v, af, ab):
        lg = [heads(jax.nn.log_sigmoid((a @ w_g2[d] + b_g2[d]).astype(F32)) / GLA_GATE_NORM, GLA_HEADS)
              for d, a in enumerate((af, ab))]
        return (heads(q, GLA_HEADS).astype(F32) * GLA_DK ** -0.5, heads(k, GLA_HEADS).astype(F32),
                heads(v, GLA_HEADS).astype(F32), lg[0], lg[1])

    lq, lk, lv, laf, lab = gla_prep(gq, gk, gv, gaf, gab)
    cq, ck, cv, caf, cab = gla_prep(cgq, cgk, cgv, cgaf, cgab)
    s0 = jnp.zeros((B, GLA_HEADS, GLA_DK, GLA_DV), F32)
    o_cf, s_f = gla_chunk_scan(cq, ck, cv, caf, s0)
    o_cb, s_b = gla_chunk_scan(rev(cq), rev(ck), rev(cv), rev(cab), s0)
    o_f, _ = gla_chunk_scan(lq, lk, lv, laf, s_f)
    o_b, _ = gla_chunk_scan(rev(lq), rev(lk), rev(lv), rev(lab), s_b)
    gla_lat = merge_heads(head_rmsnorm(o_f + rev(o_b), gla_g)).astype(h.dtype) * jax.nn.silu(gr)

    def mla_prep(q_lat, kv_lat):
        q = heads(rmsnorm(q_lat, q_norm) @ w_uq, MLA_HEADS)
        kv = heads(rmsnorm(kv_lat, kv_norm) @ w_ukv, MLA_HEADS)
        return q[..., :MLA_NOPE], q[..., MLA_NOPE:], kv[..., :MLA_NOPE], kv[..., MLA_NOPE:]

    qn, qr, kn, v = mla_prep(mq, mkv)
    cqn, cqr, ckn, cvv = mla_prep(cmq, cmkv)
    qr = apply_rope(qr, cos, sin)
    kr = apply_rope(mkr, cos, sin)
    kn_all = jnp.concatenate([kn, ckn], axis=2)
    kr_all = jnp.concatenate([kr, cmkr], axis=1)
    v_all = jnp.concatenate([v, cvv], axis=2)
    nblk = T // MLA_QBLOCK
    qn_b = jnp.moveaxis(qn.reshape(B, MLA_HEADS, nblk, MLA_QBLOCK, MLA_NOPE), 2, 0)
    qr_b = jnp.moveaxis(qr.reshape(B, MLA_HEADS, nblk, MLA_QBLOCK, MLA_ROPE), 2, 0)
    o = lax.map(lambda qs: mla_attend(qs[0], qs[1], kn_all, kr_all, v_all), (qn_b, qr_b))
    mla_lat = merge_heads(jnp.moveaxis(o, 0, 2).reshape(B, MLA_HEADS, T, MLA_DV))

    y = jnp.concatenate([gla_lat, mla_lat], axis=-1) @ w_out
    if not need_ctx:
        return y, None
    gla_ctx = merge_heads(head_rmsnorm(o_cf + rev(o_cb), gla_g)).astype(hc.dtype) * jax.nn.silu(cgr)
    mla_ctx = merge_heads(mla_attend(cqn, cqr, ckn, cmkr, cvv))
    yc = jnp.concatenate([gla_ctx, mla_ctx], axis=-1) @ w_out
    return y, yc


def odd_mixer(h, hc, cos, sin, w_in, log_decay, ret_g, w_out, need_ctx):
    B = h.shape[0]
    lq, lk, lv, lg_gate = _split(h @ w_in, ODD_SIZES)
    cq, ck, cv, cg_gate = _split(hc @ w_in, ODD_SIZES)

    def prep(q, k, v):
        return (heads(q, RET_HEADS).astype(F32), heads(k, RET_HEADS).astype(F32) * RET_DK ** -0.5,
                heads(v, RET_HEADS).astype(F32))

    lq, lk, lv = prep(lq, lk, lv)
    cq, ck, cv = prep(cq, ck, cv)
    lq = apply_rope(lq, cos, sin)
    lk = apply_rope(lk, cos, sin)
    log_gamma = -jnp.exp(log_decay.astype(F32))
    s0 = jnp.zeros((B, RET_HEADS, RET_DK, RET_DV), F32)
    o_cf, s_f = retention_chunk_scan(cq, ck, cv, log_gamma[0], s0)
    o_cb, s_b = retention_chunk_scan(rev(cq), rev(ck), rev(cv), log_gamma[1], s0)
    o_f, _ = retention_chunk_scan(lq, lk, lv, log_gamma[0], s_f)
    o_b, _ = retention_chunk_scan(rev(lq), rev(lk), rev(lv), log_gamma[1], s_b)
    y = (merge_heads(head_groupnorm(o_f + rev(o_b), ret_g)).astype(h.dtype) * jax.nn.silu(lg_gate)) @ w_out
    if not need_ctx:
        return y, None
    yc = (merge_heads(head_groupnorm(o_cf + rev(o_cb), ret_g)).astype(hc.dtype) * jax.nn.silu(cg_gate)) @ w_out
    return y, yc


def swiglu(h, wg, wu, wd):
    return (jax.nn.silu(h @ wg) * (h @ wu)) @ wd


def moe_ffn(h, w_router, w_gate, w_up, w_down):
    logits = (h @ w_router).astype(F32)
    top_val, top_idx = lax.top_k(logits, TOP_K)
    weights = jax.nn.softmax(top_val, axis=-1)
    gates = jnp.sum(jax.nn.one_hot(top_idx, N_EXPERTS, dtype=F32) * weights[..., None], axis=-2)
    y = jnp.zeros_like(h)
    for e in range(N_EXPERTS):
        y = y + gates[..., e:e + 1].astype(h.dtype) * swiglu(h, w_gate[e], w_up[e], w_down[e])
    return y


def setup_inputs(seed: int = 0) -> dict:
    key = jax.random.key(seed)
    ks = iter(jax.random.split(key, 40))

    def normal(shape, scale=1.0):
        return jax.random.normal(next(ks), shape, F32) * scale

    def nrm(shape, fan_in, scale=1.0):
        return normal(shape, scale * fan_in ** -0.5)

    def gain(shape):
        return 1.0 + normal(shape, 0.02)

    ret_init = jnp.log(-jnp.log1p(-(2.0 ** (-5.0 - jnp.arange(RET_HEADS, dtype=F32)))))
    return {
        "x": normal((BATCH, SEQ, D_MODEL)),
        "c": normal((BATCH, D_MODEL)),
        "ctx": normal((BATCH, CTX_LEN, D_MODEL)),
        "c_ctx": normal((D_MODEL,)),
        "ada_w": nrm((DEPTH, D_MODEL, 6 * D_MODEL), D_MODEL, 0.5),
        "ada_b": normal((DEPTH, 6 * D_MODEL), 0.02),
        "norm_mix": gain((DEPTH, D_MODEL)),
        "norm_ffn": gain((DEPTH, D_MODEL)),
        "norm_final": gain((D_MODEL,)),
        "ev_w_in": nrm((N_EVEN, D_MODEL, EVEN_IN), D_MODEL),
        "gla_w_gate2": nrm((N_EVEN, 2, GLA_GATE_RANK, GLA_HEADS * GLA_DK), GLA_GATE_RANK),
        "gla_b_gate2": normal((N_EVEN, 2, GLA_HEADS * GLA_DK), 0.1),
        "gla_norm": gain((N_EVEN, GLA_DV)),
        "mla_q_norm": gain((N_EVEN, MLA_Q_RANK)),
        "mla_w_uq": nrm((N_EVEN, MLA_Q_RANK, MLA_HEADS * (MLA_NOPE + MLA_ROPE)), MLA_Q_RANK),
        "mla_kv_norm": gain((N_EVEN, MLA_KV_RANK)),
        "mla_w_ukv": nrm((N_EVEN, MLA_KV_RANK, MLA_HEADS * (MLA_NOPE + MLA_DV)), MLA_KV_RANK),
        "ev_w_out": nrm((N_EVEN, EVEN_MIX, D_MODEL), EVEN_MIX),
        "ffn_w_gate": nrm((N_EVEN, D_MODEL, D_FF), D_MODEL),
        "ffn_w_up": nrm((N_EVEN, D_MODEL, D_FF), D_MODEL),
        "ffn_w_down": nrm((N_EVEN, D_FF, D_MODEL), D_FF),
        "od_w_in": nrm((N_ODD, D_MODEL, ODD_IN), D_MODEL),
        "ret_log_decay": ret_init[None, None, :] + normal((N_ODD, 2, RET_HEADS), 0.02),
        "ret_norm": gain((N_ODD, RET_DV)),
        "od_w_out": nrm((N_ODD, ODD_MIX, D_MODEL), ODD_MIX),
        "moe_router": nrm((N_ODD, D_MODEL, N_EXPERTS), D_MODEL),
        "moe_w_gate": nrm((N_ODD, N_EXPERTS, D_MODEL, D_FF), D_MODEL),
        "moe_w_up": nrm((N_ODD, N_EXPERTS, D_MODEL, D_FF), D_MODEL),
        "moe_w_down": nrm((N_ODD, N_EXPERTS, D_FF, D_MODEL), D_FF),
    }


def reference(x, c, ctx, c_ctx, ada_w, ada_b, norm_mix, norm_ffn, norm_final,
              ev_w_in, gla_w_gate2, gla_b_gate2, gla_norm, mla_q_norm, mla_w_uq, mla_kv_norm, mla_w_ukv,
              ev_w_out, ffn_w_gate, ffn_w_up, ffn_w_down,
              od_w_in, ret_log_decay, ret_norm, od_w_out, moe_router, moe_w_gate, moe_w_up, moe_w_down):
    T = x.shape[1]
    ROWS = T // GRID_W
    cos_m, sin_m = axial_rope(ROWS, MLA_ROPE)
    cos_r, sin_r = axial_rope(ROWS, RET_DK)
    xc = ctx
    for i in range(DEPTH):
        last = i == DEPTH - 1
        m_lat = (jax.nn.silu(c) @ ada_w[i] + ada_b[i])[:, None, :]
        m_ctx = (jax.nn.silu(c_ctx) @ ada_w[i] + ada_b[i])[None, None, :]
        sh_a, sc_a, g_a, sh_f, sc_f, g_f = jnp.split(m_lat, 6, axis=-1)
        csh_a, csc_a, cg_a, csh_f, csc_f, cg_f = jnp.split(m_ctx, 6, axis=-1)

        h = rmsnorm(x, norm_mix[i]) * (1.0 + sc_a) + sh_a
        hc = rmsnorm(xc, norm_mix[i]) * (1.0 + csc_a) + csh_a
        j = i // 2
        if i % 2 == 0:
            y, yc = even_mixer(h, hc, cos_m, sin_m, ev_w_in[j], gla_w_gate2[j], gla_b_gate2[j], gla_norm[j],
                               mla_q_norm[j], mla_w_uq[j], mla_kv_norm[j], mla_w_ukv[j], ev_w_out[j],
                               not last)
        else:
            y, yc = odd_mixer(h, hc, cos_r, sin_r, od_w_in[j], ret_log_decay[j], ret_norm[j], od_w_out[j],
                              not last)
        x = x + g_a * y
        h = rmsnorm(x, norm_ffn[i]) * (1.0 + sc_f) + sh_f
        if i % 2 == 0:
            x = x + g_f * swiglu(h, ffn_w_gate[j], ffn_w_up[j], ffn_w_down[j])
        else:
            x = x + g_f * moe_ffn(h, moe_router[j], moe_w_gate[j], moe_w_up[j], moe_w_down[j])

        if not last:
            xc = xc + cg_a * yc
            hc = rmsnorm(xc, norm_ffn[i]) * (1.0 + csc_f) + csh_f
            if i % 2 == 0:
                xc = xc + cg_f * swiglu(hc, ffn_w_gate[j], ffn_w_up[j], ffn_w_down[j])
            else:
                xc = xc + cg_f * moe_ffn(hc, moe_router[j], moe_w_gate[j], moe_w_up[j], moe_w_down[j])
    return rmsnorm(x, norm_final)
```

```cpp
#include <hip/hip_runtime.h>
#include <cstdio>
#include <cstdint>

#define GAS __attribute__((address_space(1)))
#define LAS __attribute__((address_space(3)))
typedef unsigned short bf16;
typedef short bf16x8 __attribute__((ext_vector_type(8)));
typedef short s16x4 __attribute__((ext_vector_type(4)));
typedef float f32x2 __attribute__((ext_vector_type(2)));
typedef float f32x4 __attribute__((ext_vector_type(4)));
typedef float f32x16 __attribute__((ext_vector_type(16)));
typedef unsigned u32x2 __attribute__((ext_vector_type(2)));
typedef unsigned u32x4 __attribute__((ext_vector_type(4)));

constexpr int D = 2048, NB = 2, T = 16384, CTX = 256, SA = T + CTX  , MALL = NB * SA  , MLAT = NB * T;
constexpr int DFF = 5632, NEXP = 8;
constexpr float EPS = 1e-6f;
constexpr int N0 = 4608, C_GQ = 0, C_GK = 512, C_GV = 1024, C_GR = 2048, C_MQ = 3072, C_MKV = 3840, C_MKR = 4352, C_GAF = 4416, C_GAB = 4432;
constexpr int N1 = 8192;
constexpr int NCH = SA / 128;
constexpr int MOE_ROWS = 2 * MLAT + NEXP * 256;

constexpr size_t MiB = 1u << 20;
constexpr size_t WS_CTL = 0, CTL_ZERO_BYTES = 1 * MiB;
constexpr size_t WS_MOD = 1 * MiB;
constexpr size_t WS_XC = 2 * MiB;
constexpr size_t WS_TOPI = 6 * MiB;
constexpr size_t WS_ROPE_M = 8 * MiB;
constexpr size_t WS_ROPE_R = 12 * MiB;
constexpr int ROPE_M_N = 320 * 16, ROPE_R_N = 320 * 64;
constexpr size_t WS_W_IN0 = 28 * MiB, WS_W_UQ = 46 * MiB, WS_W_UKV = 49 * MiB, WS_W_OUT0 = 51 * MiB, WS_W_GU = 59 * MiB, WS_W_DN = 103 * MiB, WS_W_IN1 = 125 * MiB, WS_W_OUT1 = 157 * MiB;
constexpr size_t WS_H = 168 * MiB;
constexpr size_t WS_BIG = 298 * MiB;
constexpr size_t WS_P0 = WS_BIG;
constexpr size_t WS_QLAT = 591 * MiB, WS_KVLAT = 640 * MiB, WS_Q = 673 * MiB, WS_KV = 771 * MiB, WS_KR = 901 * MiB;
constexpr size_t WS_GQK = 906 * MiB;
constexpr size_t GQK_STRIDE = (size_t)MALL * 512 * 2;
constexpr size_t WS_GE = 1036 * MiB;
constexpr size_t WS_GWS = 1038 * MiB;
constexpr size_t WS_MIX0 = 1168 * MiB;
constexpr size_t WS_HID = WS_BIG;
constexpr size_t WS_P1 = WS_BIG;
constexpr size_t WS_RWS = 1078 * MiB;
constexpr size_t WS_MIX1 = WS_H;
constexpr size_t WS_H8 = WS_H;
constexpr size_t WS_HG = WS_BIG;
constexpr size_t WS_HIDM = 430 * MiB;
constexpr size_t WS_Y = 793 * MiB;
constexpr size_t WS_WMOE = 1598 * MiB;
constexpr size_t WS_WMOE_DN = 28 * MiB;
constexpr size_t WS_END = 1774 * MiB;

constexpr int CW_TMO = 0, CW_CODE = 1;
constexpr int CW_BAR = 4096;
constexpr int CW_MOE = 8192;
constexpr int CW_CQ = 12288;
constexpr int CQ_GU_ROUNDS = NEXP * 2 * 5632 / 64;
constexpr int CQ_DN_ROUNDS = NEXP * 5632 / 64;

constexpr int SCR_BYTES = 143360;
constexpr int MISC_OFF = SCR_BYTES;
constexpr int LDS_BYTES = 147456;
constexpr int NWAVES = 8, NT = 512;

#define RLX_AGENT __ATOMIC_RELAXED, __HIP_MEMORY_SCOPE_AGENT
#define LDS_WAIT() asm volatile("s_waitcnt lgkmcnt(0)" ::: "memory")
#define VM_WAIT() asm volatile("s_waitcnt vmcnt(0)" ::: "memory")
#define SBAR() __builtin_amdgcn_sched_barrier(0)

__device__ __forceinline__ unsigned cvtpk(float lo, float hi) { unsigned r; asm volatile("v_cvt_pk_bf16_f32 %0, %1, %2" : "=v"(r) : "v"(lo), "v"(hi)); return r; }
__device__ __forceinline__ float bflo(unsigned w) { return __uint_as_float(w << 16); }
__device__ __forceinline__ float bfhi(unsigned w) { return __uint_as_float(w & 0xffff0000u); }
__device__ __forceinline__ float bf2f(bf16 b) { return __uint_as_float(((unsigned)b) << 16); }
__device__ __forceinline__ bf16 f2bf(float f) { return (bf16)(cvtpk(f, f) & 0xffffu); }
__device__ __forceinline__ bf16 f2bf_sw(float f) { const unsigned u = __float_as_uint(f); return (bf16)((u + 0x7fffu + ((u >> 16) & 1u)) >> 16); }
__device__ __forceinline__ float silu_f(float x) { return x * __builtin_amdgcn_rcpf(1.f + __builtin_amdgcn_exp2f(x * -1.4426950408889634f)); }
__device__ __forceinline__ float wave_sum(float v) {
#pragma unroll
    for (int o = 1; o < 64; o <<= 1) v += __shfl_xor(v, o);
    return v;
}
__device__ __forceinline__ int crow(int r, int hi) { return (r & 3) + 8 * (r >> 2) + 4 * hi; }

namespace pg8 {
constexpr int BM = 256, BK = 64, HALF = 128, HTB = HALF * BK * 2, STAGE_BYTES = 8 * HTB, NXCD = 8, WGM = 4;
__host__ __device__ __forceinline__ int lds_byte(int r, int c) { const int st = (r >> 4) * 2 + (c >> 5), rr = r & 15, cc = c & 31, ob = rr * 64 + cc * 2; return st * 1024 + (ob ^ (((ob >> 9) & 1) << 5)); }
__host__ __device__ __forceinline__ void stage_rc(int b, int& R, int& C) { const int st = b / 1024, sb = b % 1024, swz = sb ^ (((sb >> 9) & 1) << 5); R = (st >> 1) * 16 + swz / 64; C = (st & 1) * 32 + (swz % 64) / 2; }
__host__ __device__ __forceinline__ int perm32(int rho) { const int n = rho >> 4, i = rho & 15; return 8 * (i >> 2) + 4 * n + (i & 3); }

struct Unit { int pm, pn; };
__device__ __forceinline__ const char* sptr(const char* p) { const unsigned long long v = (unsigned long long)p; const unsigned lo = __builtin_amdgcn_readfirstlane((unsigned)v), hi = __builtin_amdgcn_readfirstlane((unsigned)(v >> 32)); return (const char*)(((unsigned long long)hi << 32) | lo); }

struct DenseOrder {
    int nM, nN, nwg, G, c, skipctx; const char* A; const char* Bt; size_t tstepA, tstepB;
    __device__ void init(int nM_, int nN_, int G_, int c_, const void* A_, size_t lda_bytes, const void* Bt_, size_t ldb_bytes, int skipctx_) {
        nM = nM_; nN = nN_; nwg = nM * nN; G = G_; c = c_; A = (const char*)A_; Bt = (const char*)Bt_; tstepA = 256 * lda_bytes; tstepB = 256 * ldb_bytes; skipctx = skipctx_; }
    __device__ bool next(int i, Unit& u) const {
        const long L = (long)i * G + c; if (L >= nwg) return false;
        int wgid = (int)L; { const int q = nwg / NXCD, r = nwg % NXCD, xcd = wgid % NXCD, off = wgid / NXCD; wgid = (xcd < r ? xcd * (q + 1) : r * (q + 1) + (xcd - r) * q) + off; }
        const int nig = WGM * nN, gid = wgid / nig, fm = gid * WGM, gsz = (nM - fm) < WGM ? (nM - fm) : WGM;
        int pm = fm + ((wgid % nig) % gsz); u.pn = (wgid % nig) / gsz;
        if (skipctx && pm >= 64) pm += 1;
        u.pm = pm; return true;
    }
    __device__ __forceinline__ const char* a_ptr(const Unit& u) const { return A + (size_t)u.pm * tstepA; }
    __device__ __forceinline__ const char* b_ptr(const Unit& u) const { return Bt + (size_t)u.pn * tstepB; }
};
struct GroupedOrder {
    int nM, nN, nwg, G, c; const char* A; const char* Bt; size_t tstepA, tstepB, estride; int ts[NEXP + 1];
    __device__ bool next(int i, Unit& u) const {
        const long L = (long)i * G + c; if (L >= nwg) return false;
        int wgid = (int)L; { const int q = nwg / NXCD, r = nwg % NXCD, xcd = wgid % NXCD, off = wgid / NXCD; wgid = (xcd < r ? xcd * (q + 1) : r * (q + 1) + (xcd - r) * q) + off; }
        const int nig = WGM * nN, gid = wgid / nig, fm = gid * WGM, gsz = (nM - fm) < WGM ? (nM - fm) : WGM;
        u.pm = fm + ((wgid % nig) % gsz); u.pn = (wgid % nig) / gsz; return true;
    }
    __device__ __forceinline__ const char* a_ptr(const Unit& u) const { return A + (size_t)u.pm * tstepA; }
    __device__ __forceinline__ const char* b_ptr(const Unit& u) const {
        int e = 0;
#pragma unroll
        for (int j = 1; j < NEXP; ++j) e += (u.pm >= ts[j]) ? 1 : 0;
        return Bt + (size_t)e * estride + (size_t)u.pn * tstepB; }
};

typedef int v8i __attribute__((ext_vector_type(8)));
typedef int v4i __attribute__((ext_vector_type(4)));
template <class Epi, class Sched, bool FP8 = false, bool ALIGN_EPI = true, bool SP2 = true>
__device__ __forceinline__ void gemm_phase(LAS unsigned char* lds, const int Kb, const int ldab, const int ldbb, const Sched& S, const Epi& E) {
    const int tid = threadIdx.x, wid = __builtin_amdgcn_readfirstlane(tid >> 6), lane = tid & 63, wr = wid >> 2, wc = wid & 3, fr = lane & 15, fq = lane >> 4;
    const int nt = Kb / 128;
    unsigned voffA[2], voffB[2];
#pragma unroll
    for (int i = 0; i < 2; ++i) { int R, C; stage_rc(tid * 16 + i * 8192, R, C); const int Rb = Epi::PERM ? ((R & ~31) + perm32(R & 31)) : R;
        voffA[i] = (unsigned)(R * ldab + C * 2); voffB[i] = (unsigned)(Rb * ldbb + C * 2); }
    const size_t kstep = (size_t)(BK * 2);
    const size_t hstepA = (size_t)HALF * ldab, hstepB = (size_t)HALF * ldbb;
    const unsigned ldsw = (unsigned)wid * 1024u;
    const int aoff = lds_byte(wr * 64 + fr, fq * 8), boff = lds_byte(wc * 32 + fr, fq * 8);
#define PG8_SA(b, h) (((b) * 2 + (h)) * HTB)
#define PG8_SB(b, h) ((4 + (b) * 2 + (h)) * HTB)
#define PG8_STAGE(bufoff, gbase, voff) do { _Pragma("unroll") for (int _i = 0; _i < 2; ++_i) \
        __builtin_amdgcn_global_load_lds((const unsigned*)((const char*)(gbase) + (voff)[_i]), (LAS unsigned*)(lds + (bufoff) + ldsw + _i * 8192), 16, 0, 0); } while (0)
#define PG8_LDA(dst, b, h) do { _Pragma("unroll") for (int m = 0; m < 4; ++m) _Pragma("unroll") for (int k = 0; k < 2; ++k) dst[m][k] = *(const LAS bf16x8*)(lds + PG8_SA(b, h) + aoff + m * 2048 + k * 1024); } while (0)
#define PG8_LDB(dst, b, h) do { _Pragma("unroll") for (int n = 0; n < 2; ++n) _Pragma("unroll") for (int k = 0; k < 2; ++k) dst[n][k] = *(const LAS bf16x8*)(lds + PG8_SB(b, h) + boff + n * 2048 + k * 1024); } while (0)
#define PG8_CAT(x) __builtin_shufflevector(__builtin_bit_cast(v4i, x[0]), __builtin_bit_cast(v4i, x[1]), 0, 1, 2, 3, 4, 5, 6, 7)
#define PG8_MMA(ai, bj, At, Bt) do { __builtin_amdgcn_s_setprio(1); if constexpr (FP8) { _Pragma("unroll") for (int m = 0; m < 4; ++m) _Pragma("unroll") for (int n = 0; n < 2; ++n) \
        { const v8i a8_ = PG8_CAT(Bt[n]), b8_ = PG8_CAT(At[m]); asm volatile("v_mfma_scale_f32_16x16x128_f8f6f4 %0, %1, %2, %0, %3, %3 op_sel_hi:[0,0,0]" : "+v"(acc[ai][bj][m][n]) : "v"(a8_), "v"(b8_), "v"(one8)); } } else { \
        _Pragma("unroll") for (int m = 0; m < 4; ++m) _Pragma("unroll") for (int n = 0; n < 2; ++n) _Pragma("unroll") for (int k = 0; k < 2; ++k) \
        acc[ai][bj][m][n] = __builtin_amdgcn_mfma_f32_16x16x32_bf16(Bt[n][k], At[m][k], acc[ai][bj][m][n], 0, 0, 0); } __builtin_amdgcn_s_setprio(0); } while (0)
#define PG8_WAIT_V(n) asm volatile("s_waitcnt vmcnt(" #n ")" ::: "memory")
#define PG8_WAIT_L(n) asm volatile("s_waitcnt lgkmcnt(" #n ")" ::: "memory")
#define PG8_BAR __builtin_amdgcn_s_barrier()
#define PG8_SCHED __builtin_amdgcn_sched_barrier(0)
    Unit cur, nxt; int ui = 0;
    if (!S.next(0, cur)) return;
    f32x4 acc[2][2][4][2];
#pragma unroll
    for (int a = 0; a < 2; ++a)
#pragma unroll
        for (int b = 0; b < 2; ++b)
#pragma unroll
            for (int m = 0; m < 4; ++m)
#pragma unroll
                for (int n = 0; n < 2; ++n) acc[a][b][m][n] = (f32x4){0.f, 0.f, 0.f, 0.f};
    bf16x8 At[4][2], B0[2][2], B1[2][2];
    int one8 = 0x7f7f7f7f; asm volatile("" : "+v"(one8));
    const char* cA = sptr(S.a_ptr(cur)); const char* cB = sptr(S.b_ptr(cur));
    if constexpr (SP2) {
        PG8_STAGE(PG8_SB(0, 0), cB, voffB); PG8_STAGE(PG8_SB(0, 1), cB + hstepB, voffB); PG8_STAGE(PG8_SA(0, 0), cA, voffA); PG8_STAGE(PG8_SA(0, 1), cA + hstepA, voffA);
        if (wr == 1) PG8_BAR;
        PG8_WAIT_V(2); PG8_BAR;
        PG8_STAGE(PG8_SB(1, 0), cB + kstep, voffB); PG8_STAGE(PG8_SA(1, 0), cA + kstep, voffA); PG8_STAGE(PG8_SB(1, 1), cB + hstepB + kstep, voffB);
        PG8_WAIT_V(6); PG8_BAR;
    } else {
        PG8_STAGE(PG8_SB(0, 0), cB, voffB); PG8_STAGE(PG8_SA(0, 0), cA, voffA); PG8_STAGE(PG8_SB(0, 1), cB + hstepB, voffB); PG8_STAGE(PG8_SA(0, 1), cA + hstepA, voffA);
        if (wr == 1) PG8_BAR;
        PG8_WAIT_V(4); PG8_BAR;
        PG8_STAGE(PG8_SB(1, 0), cB + kstep, voffB); PG8_STAGE(PG8_SA(1, 0), cA + kstep, voffA); PG8_STAGE(PG8_SB(1, 1), cB + hstepB + kstep, voffB);
        PG8_WAIT_V(6); PG8_BAR;
    }
    for (;;) {
        const bool has_next = S.next(ui + 1, nxt);
        const char* nA = sptr(has_next ? S.a_ptr(nxt) : cA); const char* nB = sptr(has_next ? S.b_ptr(nxt) : cB);
        for (int t = 0; t < nt; t += 2) {
            const bool last = (t == nt - 2);
            const char* a1 = cA + (size_t)(t + 1) * kstep;
            const char* a2 = sptr(last ? nA : cA + (size_t)(t + 2) * kstep); const char* b2 = sptr(last ? nB : cB + (size_t)(t + 2) * kstep);
            const char* a3 = a2 + kstep; const char* b3 = b2 + kstep;
            if constexpr (SP2) {
            PG8_LDB(B0, 0, 0); PG8_LDB(B1, 0, 1); PG8_SCHED; PG8_LDA(At, 0, 0); PG8_STAGE(PG8_SA(1, 1), a1 + hstepA, voffA);
            PG8_WAIT_V(8); PG8_WAIT_L(0); PG8_BAR; PG8_MMA(0, 0, At, B0); PG8_MMA(0, 1, At, B1); PG8_BAR; PG8_SCHED;
            PG8_LDA(At, 0, 1); PG8_STAGE(PG8_SB(0, 0), b2, voffB); PG8_STAGE(PG8_SB(0, 1), b2 + hstepB, voffB); PG8_STAGE(PG8_SA(0, 0), a2, voffA);
            PG8_WAIT_V(8); PG8_WAIT_L(0); PG8_BAR; PG8_MMA(1, 0, At, B0); PG8_MMA(1, 1, At, B1); PG8_BAR; PG8_SCHED;
            PG8_LDB(B0, 1, 0); PG8_LDB(B1, 1, 1); PG8_SCHED; PG8_LDA(At, 1, 0); PG8_STAGE(PG8_SA(0, 1), a2 + hstepA, voffA);
            PG8_WAIT_V(8); PG8_WAIT_L(0); PG8_BAR; PG8_MMA(0, 0, At, B0); PG8_MMA(0, 1, At, B1); PG8_BAR; PG8_SCHED;
            PG8_LDA(At, 1, 1); PG8_STAGE(PG8_SB(1, 0), b3, voffB); PG8_STAGE(PG8_SB(1, 1), b3 + hstepB, voffB); PG8_STAGE(PG8_SA(1, 0), a3, voffA);
            PG8_WAIT_V(8); PG8_WAIT_L(0); PG8_BAR; PG8_MMA(1, 0, At, B0); PG8_MMA(1, 1, At, B1); PG8_BAR; PG8_SCHED;
            } else {
            PG8_LDB(B0, 0, 0); PG8_SCHED; PG8_LDA(At, 0, 0); PG8_STAGE(PG8_SA(1, 1), a1 + hstepA, voffA);
            PG8_WAIT_L(8); PG8_BAR; PG8_WAIT_L(0); PG8_MMA(0, 0, At, B0); PG8_BAR; PG8_SCHED;
            PG8_LDB(B1, 0, 1); PG8_STAGE(PG8_SB(0, 0), b2, voffB);
            PG8_BAR; PG8_WAIT_L(0); PG8_MMA(0, 1, At, B1); PG8_BAR;
            PG8_LDA(At, 0, 1); PG8_STAGE(PG8_SA(0, 0), a2, voffA);
            PG8_BAR; PG8_WAIT_L(0); PG8_MMA(1, 0, At, B0); PG8_BAR; PG8_SCHED;
            PG8_STAGE(PG8_SB(0, 1), b2 + hstepB, voffB);
            PG8_WAIT_V(6); PG8_BAR; PG8_MMA(1, 1, At, B1); PG8_BAR;
            PG8_LDB(B0, 1, 0); PG8_SCHED; PG8_LDA(At, 1, 0); PG8_STAGE(PG8_SA(0, 1), a2 + hstepA, voffA);
            PG8_WAIT_L(8); PG8_BAR; PG8_WAIT_L(0); PG8_MMA(0, 0, At, B0); PG8_BAR; PG8_SCHED;
            PG8_LDB(B1, 1, 1); PG8_STAGE(PG8_SB(1, 0), b3, voffB);
            PG8_BAR; PG8_WAIT_L(0); PG8_MMA(0, 1, At, B1); PG8_BAR;
            PG8_LDA(At, 1, 1); PG8_STAGE(PG8_SA(1, 0), a3, voffA);
            PG8_BAR; PG8_WAIT_L(0); PG8_MMA(1, 0, At, B0); PG8_BAR; PG8_SCHED;
            PG8_STAGE(PG8_SB(1, 1), b3 + hstepB, voffB);
            PG8_WAIT_V(6); PG8_BAR; PG8_MMA(1, 1, At, B1); PG8_BAR;
            }
        }
        if constexpr (ALIGN_EPI) { if (wr == 0) PG8_BAR; }
        if constexpr (FP8) asm volatile("s_nop 15\n\ts_nop 15" ::: "memory");
        E(acc, cur, wr, wc, fr, fq);
        if (!has_next) break;
#pragma unroll
        for (int a = 0; a < 2; ++a)
#pragma unroll
            for (int b = 0; b < 2; ++b)
#pragma unroll
                for (int m = 0; m < 4; ++m)
#pragma unroll
                    for (int n = 0; n < 2; ++n) acc[a][b][m][n] = (f32x4){0.f, 0.f, 0.f, 0.f};
        cur = nxt; cA = nA; cB = nB; ++ui;
        if constexpr (ALIGN_EPI) { if (wr == 1) PG8_BAR; }
    }
    PG8_WAIT_V(0);
    if constexpr (!ALIGN_EPI) { if (wr == 0) PG8_BAR; }
    PG8_BAR;
#undef PG8_SA
#undef PG8_SB
#undef PG8_STAGE
#undef PG8_LDA
#undef PG8_LDB
#undef PG8_MMA
#undef PG8_CAT
#undef PG8_WAIT_V
#undef PG8_WAIT_L
#undef PG8_BAR
#undef PG8_SCHED
}
}

typedef pg8::Unit GUnit;
__device__ __forceinline__ u32x4 pack8(const f32x4& v0, const f32x4& v1) { u32x4 w; w.x = cvtpk(v0[0], v0[1]); w.y = cvtpk(v0[2], v0[3]); w.z = cvtpk(v1[0], v1[1]); w.w = cvtpk(v1[2], v1[3]); return w; }

struct EpiStoreBf16 {
    static constexpr bool PERM = true;
    bf16* O; int ldc; float sc = 1.f;
    __device__ __forceinline__ void operator()(const f32x4 (&acc)[2][2][4][2], const GUnit& u, int wr, int wc, int fr, int fq) const {
        asm volatile("" : "+v"(fr), "+v"(fq));
        const int row0 = u.pm * 256 + wr * 64 + fr, col0 = u.pn * 256 + wc * 32 + 8 * fq;
#pragma unroll
        for (int ai = 0; ai < 2; ++ai)
#pragma unroll
            for (int m = 0; m < 4; ++m) { bf16* rowp = O + (size_t)(row0 + ai * 128 + m * 16) * ldc + col0;
#pragma unroll
                for (int bj = 0; bj < 2; ++bj) *(GAS u32x4*)(rowp + bj * 128) = pack8(acc[ai][bj][m][0] * sc, acc[ai][bj][m][1] * sc); }
    }
};
struct EpiQRope {
    static constexpr bool PERM = true;
    bf16* Q; const float* cs; const float* sn; float qscale;
    __device__ __forceinline__ void operator()(const f32x4 (&acc)[2][2][4][2], const GUnit& u, int wr, int wc, int fr, int fq) const {
        asm volatile("" : "+v"(fr), "+v"(fq));
        const int w = u.pm % 65; const bool latent = w < 64;
        const int rit0 = wr * 64 + fr;
#pragma unroll
        for (int ai = 0; ai < 2; ++ai)
#pragma unroll
            for (int m = 0; m < 4; ++m) { const int rit = rit0 + ai * 128 + m * 16; const int t = w * 256 + rit;
                bf16* rowp = Q + (size_t)(u.pm * 256 + rit) * 1536;
#pragma unroll
                for (int bj = 0; bj < 2; ++bj) { const int c0 = u.pn * 256 + bj * 128 + wc * 32 + 8 * fq; const int cc = c0 % 192;
                    f32x4 v0 = acc[ai][bj][m][0], v1 = acc[ai][bj][m][1];
                    if (cc >= 128 && latent) { const int i0 = (cc - 128) >> 1; const int ro = ((i0 & 16) ? 256 + (t & 63) : (t >> 6)) * 16 + (i0 & 15); const f32x4 c4 = *(const GAS f32x4*)(cs + ro), s4 = *(const GAS f32x4*)(sn + ro);
                        f32x4 a0, a1; a0[0] = v0[0] * c4[0] - v0[1] * s4[0]; a0[1] = v0[0] * s4[0] + v0[1] * c4[0]; a0[2] = v0[2] * c4[1] - v0[3] * s4[1]; a0[3] = v0[2] * s4[1] + v0[3] * c4[1];
                        a1[0] = v1[0] * c4[2] - v1[1] * s4[2]; a1[1] = v1[0] * s4[2] + v1[1] * c4[2]; a1[2] = v1[2] * c4[3] - v1[3] * s4[3]; a1[3] = v1[2] * s4[3] + v1[3] * c4[3]; v0 = a0; v1 = a1; }
                    v0 = v0 * qscale; v1 = v1 * qscale;
                    *(GAS u32x4*)(rowp + c0) = pack8(v0, v1); } }
    }
};
constexpr int P1LD = 12288;
constexpr size_t P1PLANE = (size_t)MALL * 256;
struct EpiIn1 {
    static constexpr bool PERM = true;
    bf16* O; const float* cs; const float* sn; const float* rld;
    __device__ __forceinline__ void operator()(const f32x4 (&acc)[2][2][4][2], const GUnit& u, int wr, int wc, int fr, int fq) const {
        asm volatile("" : "+v"(fr), "+v"(fq));
        const int w = u.pm % 65; const bool latent = w < 64; const bool qk = u.pn < 16; const bool isk = u.pn >= 8; const bool rope = qk && latent; const float ks = (qk && isk) ? 0.0625f : 1.f;
        const int hd = u.pn & 7; float lgf = 0.f, lgb = 0.f; if (qk) { lgf = -__expf(rld[hd]); lgb = -__expf(rld[8 + hd]); if (isk) { lgf = -lgf; lgb = -lgb; } }
        const int plane = qk ? (isk ? 8 : 0) + hd : 24 + (u.pn - 16);
        const int rit0 = wr * 64 + fr;
#pragma unroll
        for (int ai = 0; ai < 2; ++ai)
#pragma unroll
            for (int m = 0; m < 4; ++m) { const int rit = rit0 + ai * 128 + m * 16; const int t = w * 256 + rit; const int p = rit & 127;
                bf16* rowp = O + ((size_t)plane * MALL + (size_t)(u.pm * 256 + rit)) * 256 + wc * 32 + 8 * fq;
                const float ff = qk ? __expf(lgf * (float)(p + 1)) : 1.f, fb = qk ? __expf(lgb * (float)(128 - p)) : 1.f;
#pragma unroll
                for (int bj = 0; bj < 2; ++bj) { f32x4 v0 = acc[ai][bj][m][0], v1 = acc[ai][bj][m][1];
                    if (rope) { const int i0 = 64 * bj + 16 * wc + 4 * fq; const int ro = (bj ? 256 + (t & 63) : (t >> 6)) * 64 + (i0 & 63); const f32x4 c4 = *(const GAS f32x4*)(cs + ro), s4 = *(const GAS f32x4*)(sn + ro);
                        f32x4 a0, a1; a0[0] = v0[0] * c4[0] - v0[1] * s4[0]; a0[1] = v0[0] * s4[0] + v0[1] * c4[0]; a0[2] = v0[2] * c4[1] - v0[3] * s4[1]; a0[3] = v0[2] * s4[1] + v0[3] * c4[1];
                        a1[0] = v1[0] * c4[2] - v1[1] * s4[2]; a1[1] = v1[0] * s4[2] + v1[1] * c4[2]; a1[2] = v1[2] * c4[3] - v1[3] * s4[3]; a1[3] = v1[2] * s4[3] + v1[3] * c4[3]; v0 = a0; v1 = a1; }
                    v0 = v0 * ks; v1 = v1 * ks;
                    if (qk) { *(GAS u32x4*)(rowp + bj * 128) = pack8(v0 * ff, v1 * ff); if (isk) *(GAS u32x4*)(rowp + 8 * P1PLANE + bj * 128) = pack8(v0 * fb, v1 * fb); }
                    else *(GAS u32x4*)(rowp + bj * 128) = pack8(v0, v1); } }
    }
};
struct EpiResid {
    static constexpr bool PERM = false;
    const float* srcLat; const float* srcCtx; float* dstLat; float* dstCtx; const float* gate; float sc = 1.f;
    __device__ __forceinline__ void operator()(const f32x4 (&acc)[2][2][4][2], const GUnit& u, int wr, int wc, int fr, int fq) const {
        asm volatile("" : "+v"(fr), "+v"(fq));
        const int b = u.pm / 65, w = u.pm % 65; const float* src; float* dst; int set;
        if (w < 64) { const size_t o = ((size_t)b * T + (size_t)w * 256) * D; src = srcLat + o; dst = dstLat + o; set = b; }
        else { const size_t o = (size_t)b * CTX * D; src = srcCtx + o; dst = dstCtx + o; set = 2; }
        const int col0 = u.pn * 256 + wc * 32 + 4 * fq; const float* g = gate + (size_t)set * 12288 + col0;
        f32x4 gv[2][2];
#pragma unroll
        for (int bj = 0; bj < 2; ++bj)
#pragma unroll
            for (int n = 0; n < 2; ++n) gv[bj][n] = *(const GAS f32x4*)(g + bj * 128 + n * 16) * sc;
#pragma unroll
        for (int ai = 0; ai < 2; ++ai)
#pragma unroll
            for (int m = 0; m < 4; ++m) { const size_t p = (size_t)(wr * 64 + fr + ai * 128 + m * 16) * D + col0;
#pragma unroll
                for (int bj = 0; bj < 2; ++bj)
#pragma unroll
                    for (int n = 0; n < 2; ++n) { const f32x4 bs = *(const GAS f32x4*)(src + p + bj * 128 + n * 16); *(GAS f32x4*)(dst + p + bj * 128 + n * 16) = bs + gv[bj][n] * acc[ai][bj][m][n]; } }
    }
};
struct EpiSwiGLU {
    static constexpr bool PERM = true;
    bf16* Hd; int ldc;
    __device__ __forceinline__ void operator()(const f32x4 (&acc)[2][2][4][2], const GUnit& u, int wr, int wc, int fr, int fq) const {
        asm volatile("" : "+v"(fr), "+v"(fq));
        const int row0 = u.pm * 256 + wr * 64 + fr, col0 = u.pn * 128 + wc * 32 + 8 * fq;
#pragma unroll
        for (int ai = 0; ai < 2; ++ai)
#pragma unroll
            for (int m = 0; m < 4; ++m) { f32x4 h0, h1;
#pragma unroll
                for (int j = 0; j < 4; ++j) { h0[j] = silu_f(acc[ai][0][m][0][j]) * acc[ai][1][m][0][j]; h1[j] = silu_f(acc[ai][0][m][1][j]) * acc[ai][1][m][1][j]; }
                *(GAS u32x4*)(Hd + (size_t)(row0 + ai * 128 + m * 16) * ldc + col0) = pack8(h0, h1); }
    }
};

__device__ __forceinline__ float clamp448(float x) { return __builtin_amdgcn_fmed3f(x, -448.f, 448.f); }
__device__ __forceinline__ unsigned pack4_fp8(float a, float b, float c, float d) { int w = __builtin_amdgcn_cvt_pk_fp8_f32(clamp448(a), clamp448(b), 0, false); w = __builtin_amdgcn_cvt_pk_fp8_f32(clamp448(c), clamp448(d), w, true); return (unsigned)w; }
constexpr float W8_SCALE = 256.f;
constexpr float H8_SCALE = 8.f;
struct EpiSwiGLUto8 {
    static constexpr bool PERM = true;
    unsigned char* Hd; int ldc;
    __device__ __forceinline__ void operator()(const f32x4 (&acc)[2][2][4][2], const GUnit& u, int wr, int wc, int fr, int fq) const {
        asm volatile("" : "+v"(fr), "+v"(fq));
        const int row0 = u.pm * 256 + wr * 64 + fr, col0 = u.pn * 128 + wc * 32 + 8 * fq;
#pragma unroll
        for (int ai = 0; ai < 2; ++ai)
#pragma unroll
            for (int m = 0; m < 4; ++m) { f32x4 h0, h1;
#pragma unroll
                for (int j = 0; j < 4; ++j) { h0[j] = silu_f(acc[ai][0][m][0][j]) * (acc[ai][1][m][0][j] * H8_SCALE); h1[j] = silu_f(acc[ai][0][m][1][j]) * (acc[ai][1][m][1][j] * H8_SCALE); }
                u32x2 w; w.x = pack4_fp8(h0[0], h0[1], h0[2], h0[3]); w.y = pack4_fp8(h1[0], h1[1], h1[2], h1[3]);
                *(GAS u32x2*)(Hd + (size_t)(row0 + ai * 128 + m * 16) * ldc + col0) = w; }
    }
};
struct EpiSwiGLU8 {
    static constexpr bool PERM = true;
    unsigned char* Hd; int ldc;
    __device__ __forceinline__ void operator()(const f32x4 (&acc)[2][2][4][2], const GUnit& u, int wr, int wc, int fr, int fq) const {
        asm volatile("" : "+v"(fr), "+v"(fq));
        const int row0 = u.pm * 256 + wr * 64 + fr, col0 = u.pn * 128 + wc * 32 + 8 * fq; constexpr float si = 1.f / W8_SCALE;
#pragma unroll
        for (int ai = 0; ai < 2; ++ai)
#pragma unroll
            for (int m = 0; m < 4; ++m) { f32x4 h0, h1;
#pragma unroll
                for (int j = 0; j < 4; ++j) { h0[j] = silu_f(acc[ai][0][m][0][j] * si) * (acc[ai][1][m][0][j] * (si * H8_SCALE)); h1[j] = silu_f(acc[ai][0][m][1][j] * si) * (acc[ai][1][m][1][j] * (si * H8_SCALE)); }
                u32x2 w; w.x = pack4_fp8(h0[0], h0[1], h0[2], h0[3]); w.y = pack4_fp8(h1[0], h1[1], h1[2], h1[3]);
                *(GAS u32x2*)(Hd + (size_t)(row0 + ai * 128 + m * 16) * ldc + col0) = w; }
    }
};

#define XB_TMO      128
#define XB_XCNT(j)  (256  + 64 * (j))
#define XB_XSUB(j)  (1280 + 64 * (j))
#define XB_XGEN(j)  (2304 + 64 * (j))
#define XB_TOP      3328
#define XB_TOPGEN   3392
#define XCD_BAR_WORDS 3456
#define XB_SPIN_CAP (1u << 18)
__device__ __forceinline__ unsigned xb_ld(unsigned* p)              { return __hip_atomic_load(p, __ATOMIC_RELAXED, __HIP_MEMORY_SCOPE_AGENT); }
__device__ __forceinline__ unsigned xb_add(unsigned* p, unsigned v) { return __hip_atomic_fetch_add(p, v, __ATOMIC_RELAXED, __HIP_MEMORY_SCOPE_AGENT); }
__device__ __forceinline__ unsigned xb_xcc_id() { return (unsigned)__builtin_amdgcn_s_getreg((3 << 11) | 20) & 0xFu; }
#define XB_SPIN_TIGHT(cond, bar) do { unsigned _sp = 0; while (cond) { \
    if ((++_sp & 255u) == 0u) { if (xb_ld(&(bar)[XB_TMO])) break; if (_sp > XB_SPIN_CAP) { atomicAdd(&(bar)[XB_TMO], 1u); break; } } } } while (0)
#define XB_SPIN(cond, bar) do { unsigned _sp = 0; while (cond) { __builtin_amdgcn_s_sleep(1); \
    if ((++_sp & 255u) == 0u) { if (xb_ld(&(bar)[XB_TMO])) break; if (_sp > XB_SPIN_CAP) { atomicAdd(&(bar)[XB_TMO], 1u); break; } } } } while (0)
struct XcdBarrier { unsigned* bar; unsigned x; volatile LAS unsigned* st; };
__device__ __forceinline__ XcdBarrier xcd_barrier_post(unsigned* bar, volatile LAS unsigned* st) {
    XcdBarrier b; b.bar = bar; b.x = xb_xcc_id(); b.st = st;
    if (threadIdx.x == 0) (void)xb_add(&bar[XB_XCNT(b.x)], 1u);
    return b;
}
__device__ __forceinline__ void xcd_barrier_complete(unsigned* bar, unsigned x, unsigned& nloc, unsigned& nx) {
    const unsigned G = gridDim.x * gridDim.y * gridDim.z;
    unsigned sum, cnt, mine, sp = 0u;
    for (;;) {
        sum = 0u; cnt = 0u; mine = 0u;
#pragma unroll
        for (unsigned j = 0; j < 16; ++j) { const unsigned c = xb_ld(&bar[XB_XCNT(j)]); sum += c; cnt += (c > 0u) ? 1u : 0u; mine = (j == x) ? c : mine; }
        if (sum == G) break;
        __builtin_amdgcn_s_sleep(1);
        if ((++sp & 255u) == 0u) { if (xb_ld(&bar[XB_TMO])) break; if (sp > XB_SPIN_CAP) { atomicAdd(&bar[XB_TMO], 1u); break; } }
    }
    nloc = mine > 0u ? mine : 1u; nx = cnt > 0u ? cnt : 1u;
}
__device__ __forceinline__ void xcd_barrier(const XcdBarrier& b) {
    asm volatile("s_waitcnt vmcnt(0)" ::: "memory");
    __syncthreads();
    if (threadIdx.x == 0) {
        unsigned* bar = b.bar;
        __builtin_amdgcn_s_waitcnt(0);
        unsigned nloc = b.st[0], nx = b.st[1];
        if (nloc == 0u) { xcd_barrier_complete(bar, b.x, nloc, nx); b.st[0] = nloc; b.st[1] = nx; }
        const unsigned old = xb_add(&bar[XB_XSUB(b.x)], 1u);
        const unsigned gen = old / nloc;
        if (old + 1u == (gen + 1u) * nloc) {
            __builtin_amdgcn_fence(__ATOMIC_RELEASE, "agent");
            asm volatile("s_waitcnt vmcnt(0)" ::: "memory");
            const unsigned og = xb_add(&bar[XB_TOP], 1u);
            const unsigned tg = og / nx;
            if (og + 1u == (tg + 1u) * nx) xb_add(&bar[XB_TOPGEN], 1u);
            else XB_SPIN_TIGHT(xb_ld(&bar[XB_TOPGEN]) == tg, bar);
            __builtin_amdgcn_fence(__ATOMIC_ACQUIRE, "agent");
            xb_add(&bar[XB_XGEN(b.x)], 1u);
            asm volatile("s_waitcnt vmcnt(0)" ::: "memory");
        } else {
            XB_SPIN(xb_ld(&bar[XB_XGEN(b.x)]) == gen, bar);
            __builtin_amdgcn_fence(__ATOMIC_ACQUIRE, "agent");
            asm volatile("s_waitcnt vmcnt(0)" ::: "memory");
        }
    }
    __syncthreads();
}

__device__ __forceinline__ int v_st(int k, int c) { const int kk = (k & ~0xC) | ((k & 4) << 1) | ((k & 8) >> 1); return ((kk >> 3) * 4 + (c >> 5)) * 512 + ((kk & 7) * 32 + (c & 31)) * 2; }
__device__ __forceinline__ int v_rd_base(int lane) { return ((lane & 3) << 3) | (((lane >> 2) & 3) << 6) | (((lane >> 4) & 1) << 5) | (((lane >> 5) & 1) << 8); }
constexpr int v_rd_off(int d0, int ks, int half) { return d0 * 512 + ks * 4096 + half * 2048; }
template <int OFF> __device__ __forceinline__ s16x4 tr_read(int vb) { s16x4 r; asm volatile("ds_read_b64_tr_b16 %0, %1 offset:%2" : "=&v"(r) : "v"(vb), "i"(OFF) : "memory"); return r; }
#define PK8(L, H) (bf16x8){L[0], L[1], L[2], L[3], H[0], H[1], H[2], H[3]}
#define PK4(P, BASE, OUT) do { unsigned a0_ = cvtpk(P[BASE + 0], P[BASE + 1]), a1_ = cvtpk(P[BASE + 2], P[BASE + 3]);   \
    unsigned b0_ = cvtpk(P[BASE + 4], P[BASE + 5]), b1_ = cvtpk(P[BASE + 6], P[BASE + 7]);                              \
    auto r0_ = __builtin_amdgcn_permlane32_swap(a0_, b0_, false, false); auto r1_ = __builtin_amdgcn_permlane32_swap(a1_, b1_, false, false); \
    u32x4 w_ = {r0_[0], r1_[0], r0_[1], r1_[1]}; OUT = __builtin_bit_cast(bf16x8, w_); } while (0)
template <int D0> __device__ __forceinline__ void pv_one(f32x16& od, int vb, bf16x8 pa0, bf16x8 pa1, bf16x8 pa2, bf16x8 pa3) {
    const s16x4 l0 = tr_read<v_rd_off(D0, 0, 0)>(vb), h0 = tr_read<v_rd_off(D0, 0, 1)>(vb), l1 = tr_read<v_rd_off(D0, 1, 0)>(vb), h1 = tr_read<v_rd_off(D0, 1, 1)>(vb);
    const s16x4 l2 = tr_read<v_rd_off(D0, 2, 0)>(vb), h2 = tr_read<v_rd_off(D0, 2, 1)>(vb), l3 = tr_read<v_rd_off(D0, 3, 0)>(vb), h3 = tr_read<v_rd_off(D0, 3, 1)>(vb);
    asm volatile("s_waitcnt lgkmcnt(0)" ::: "memory"); SBAR();
    od = __builtin_amdgcn_mfma_f32_32x32x16_bf16(pa0, PK8(l0, h0), od, 0, 0, 0);
    od = __builtin_amdgcn_mfma_f32_32x32x16_bf16(pa1, PK8(l1, h1), od, 0, 0, 0);
    od = __builtin_amdgcn_mfma_f32_32x32x16_bf16(pa2, PK8(l2, h2), od, 0, 0, 0);
    od = __builtin_amdgcn_mfma_f32_32x32x16_bf16(pa3, PK8(l3, h3), od, 0, 0, 0);
}
__device__ __forceinline__ void pv_d0(f32x16* o, int vb, bf16x8 pa0, bf16x8 pa1, bf16x8 pa2, bf16x8 pa3) {
    pv_one<0>(o[0], vb, pa0, pa1, pa2, pa3); pv_one<1>(o[1], vb, pa0, pa1, pa2, pa3); pv_one<2>(o[2], vb, pa0, pa1, pa2, pa3); pv_one<3>(o[3], vb, pa0, pa1, pa2, pa3);
}


__device__ __forceinline__ void otile_write(LAS unsigned char* wbase, const f32x16* o, int r32, int hi) {
    LAS float* p = (LAS float*)wbase + (4 * hi) * 128 + r32;
#pragma unroll
    for (int d = 0; d < 4; ++d)
#pragma unroll
        for (int r = 0; r < 16; ++r) p[((r & 3) + 8 * (r >> 2)) * 128 + 32 * d] = o[d][r];
}

__device__ __forceinline__ void scan_vimg_kc(int tid, int (&kc)[2]) {
#pragma unroll
    for (int i = 0; i < 2; ++i) { const int o = (i * 8 + (tid >> 6)) * 1024 + (tid & 63) * 16; const int st = o >> 9, w = (o & 511) >> 1; const int kk = (st >> 2) * 8 + (w >> 5), c = (st & 3) * 32 + (w & 31);
        const int k = (kk & ~0xC) | ((kk & 4) << 1) | ((kk & 8) >> 1); kc[i] = (k << 8) | c; }
}

namespace mla {
constexpr int KSTR = 400, KT_BYTES = 64 * KSTR, VT_BYTES = 16384, STAGE_BYTES = VT_BYTES + KT_BYTES;
constexpr int L_WS = 3 * STAGE_BYTES, L_END = L_WS + 8 * 64 * 4;
static_assert(L_END <= 131072, "attention LDS map");
constexpr float THR = 8.f;
__device__ __forceinline__ void partialSM(f32x16& p0, f32x16& p1, float& m_reg, float& mn, float& alpha) {
    float pmax = p0[0];
#pragma unroll
    for (int r = 1; r < 16; ++r) pmax = fmaxf(pmax, p0[r]);
#pragma unroll
    for (int r = 0; r < 16; ++r) pmax = fmaxf(pmax, p1[r]);
    { auto rr = __builtin_amdgcn_permlane32_swap(__float_as_uint(pmax), __float_as_uint(pmax), false, false); pmax = fmaxf(__uint_as_float(rr[0]), __uint_as_float(rr[1])); }
    if (__builtin_expect(__all(pmax - m_reg <= THR), 1)) { mn = m_reg; alpha = 1.f; }
    else { mn = fmaxf(m_reg, pmax); alpha = __builtin_amdgcn_exp2f(m_reg - mn); m_reg = mn; }
#pragma unroll
    for (int r = 0; r < 16; ++r) p0[r] = p0[r] - mn;
#pragma unroll
    for (int r = 0; r < 16; ++r) p1[r] = p1[r] - mn;
#pragma unroll
    for (int r = 0; r < 16; ++r) p0[r] = __builtin_amdgcn_exp2f(p0[r]);
}
__device__ __forceinline__ void finishSM(f32x16& p0, f32x16& p1, float alpha, float& l_reg, bf16x8& pa0, bf16x8& pa1, bf16x8& pa2, bf16x8& pa3) {
#pragma unroll
    for (int r = 0; r < 16; ++r) p1[r] = __builtin_amdgcn_exp2f(p1[r]);
    float ps = 0;
#pragma unroll
    for (int r = 0; r < 16; ++r) ps += p0[r];
#pragma unroll
    for (int r = 0; r < 16; ++r) ps += p1[r];
    { auto rr = __builtin_amdgcn_permlane32_swap(__float_as_uint(ps), __float_as_uint(ps), false, false); ps = __uint_as_float(rr[0]) + __uint_as_float(rr[1]); }
    l_reg = l_reg * alpha + ps;
    PK4(p0, 0, pa0); PK4(p0, 8, pa1); PK4(p1, 0, pa2); PK4(p1, 8, pa3);
}
__device__ __forceinline__ void qkt(f32x16& p0, f32x16& p1, const LAS unsigned char* Ks, const bf16x8* qr, int r32, int hi) {
    p0 = f32x16{}; p1 = f32x16{};
    const LAS unsigned char* kb = Ks + r32 * KSTR + hi * 16;
#pragma unroll
    for (int d0 = 0; d0 < 12; ++d0) {
        const bf16x8 b0 = *(const LAS bf16x8*)(kb + d0 * 32);
        const bf16x8 b1 = *(const LAS bf16x8*)(kb + 32 * KSTR + d0 * 32);
        p0 = __builtin_amdgcn_mfma_f32_32x32x16_bf16(b0, qr[d0], p0, 0, 0, 0);
        p1 = __builtin_amdgcn_mfma_f32_32x32x16_bf16(b1, qr[d0], p1, 0, 0, 0); }
}
__device__ __forceinline__ void qkt_negm(f32x16& p0, f32x16& p1, const LAS unsigned char* Ks, const bf16x8* qr, float negm, int r32, int hi) {
#pragma unroll
    for (int r = 0; r < 16; ++r) { p0[r] = negm; p1[r] = negm; }
    const LAS unsigned char* kb = Ks + r32 * KSTR + hi * 16;
#pragma unroll
    for (int d0 = 0; d0 < 12; ++d0) {
        const bf16x8 b0 = *(const LAS bf16x8*)(kb + d0 * 32);
        const bf16x8 b1 = *(const LAS bf16x8*)(kb + 32 * KSTR + d0 * 32);
        p0 = __builtin_amdgcn_mfma_f32_32x32x16_bf16(b0, qr[d0], p0, 0, 0, 0);
        p1 = __builtin_amdgcn_mfma_f32_32x32x16_bf16(b1, qr[d0], p1, 0, 0, 0); }
}
__device__ __forceinline__ void partialSM_negm(f32x16& p0, f32x16& p1, float& m_reg, float& alpha) {
    float pmax = p0[0];
#pragma unroll
    for (int r = 1; r < 16; ++r) pmax = fmaxf(pmax, p0[r]);
#pragma unroll
    for (int r = 0; r < 16; ++r) pmax = fmaxf(pmax, p1[r]);
    { auto rr = __builtin_amdgcn_permlane32_swap(__float_as_uint(pmax), __float_as_uint(pmax), false, false); pmax = fmaxf(__uint_as_float(rr[0]), __uint_as_float(rr[1])); }
    if (__builtin_expect(__all(pmax <= THR), 1)) { alpha = 1.f; }
    else { const float d = fmaxf(pmax, 0.f); alpha = __builtin_amdgcn_exp2f(-d); m_reg += d;
#pragma unroll
        for (int r = 0; r < 16; ++r) { p0[r] -= d; p1[r] -= d; } }
#pragma unroll
    for (int r = 0; r < 16; ++r) p0[r] = __builtin_amdgcn_exp2f(p0[r]);
}
__device__ __forceinline__ int slot_off(int t) { int so = (t % 3) * STAGE_BYTES; asm volatile("" : "+s"(so)); return so; }
__device__ __forceinline__ void attn_unit(const bf16* __restrict__ Qb, const bf16* __restrict__ Kn, const bf16* __restrict__ Vh, const bf16* __restrict__ Kr, bf16* __restrict__ Ob, int nkeys, LAS unsigned char* lds) {
    const int tid = threadIdx.x, wid = __builtin_amdgcn_readfirstlane(tid >> 6), lane = tid & 63, r32 = lane & 31, hi = lane >> 5;
    LAS float* ws = (LAS float*)(lds + L_WS) + wid * 64; LAS float* li_l = ws; LAS float* al_l = ws + 32;
    float m_reg = -1e30f, l_reg = 0; f32x16 o[4] = {}; bf16x8 qr[12];
    const bf16* Qw = Qb + (size_t)(wid * 32 + r32) * 1536 + hi * 8;
#pragma unroll
    for (int d0 = 0; d0 < 12; ++d0) qr[d0] = *(const bf16x8*)(Qw + d0 * 16);
    int kc[2]; scan_vimg_kc(tid, kc);
    const int lbase = (int)(uintptr_t)lds + v_rd_base(lane);
    int pk[4];
#pragma unroll
    for (int i = 0; i < 4; ++i) { const int idx = (wid + 8 * i) * 64 + lane; pk[i] = ((idx / 25) << 8) | (idx % 25); }
#define DMA_TILE(t) do { const int t_ = (t); const int so_ = slot_off(t_); const size_t k0_ = (size_t)t_ * 64; \
    _Pragma("unroll") for (int i_ = 0; i_ < 2; ++i_) __builtin_amdgcn_global_load_lds((const unsigned*)(Vh + (k0_ + (kc[i_] >> 8)) * 2048 + (kc[i_] & 255)), (LAS unsigned*)(lds + so_ + (i_ * 8 + wid) * 1024), 16, 0, 0); \
    _Pragma("unroll") for (int i_ = 0; i_ < 4; ++i_) if (i_ < 3 || wid == 0) { const int row_ = pk[i_] >> 8, c_ = pk[i_] & 255; \
        const bf16* src_ = (c_ < 16) ? (Kn + (k0_ + row_) * 2048 + c_ * 8) : (c_ < 24 ? (Kr + (k0_ + row_) * 64 + (c_ - 16) * 8) : Kn); \
        __builtin_amdgcn_global_load_lds((const unsigned*)src_, (LAS unsigned*)(lds + so_ + VT_BYTES + (wid + 8 * i_) * 1024), 16, 0, 0); } } while (0)
#define KSLOT(t) (lds + slot_off(t) + VT_BYTES)
#define VSLOT(t) (lbase + slot_off(t))
#define RESC(a) do { if (__any((a) < 1.f)) { if (hi == 0) al_l[r32] = (a); asm volatile("s_waitcnt lgkmcnt(0)" ::: "memory"); \
    _Pragma("unroll") for (int d = 0; d < 4; ++d) _Pragma("unroll") for (int r = 0; r < 16; ++r) o[d][r] *= al_l[crow(r, hi)]; } } while (0)
    f32x16 pA0, pA1, pB0, pB1; float mnA, mnB, alA, alB; bf16x8 pa0, pa1, pa2, pa3; const int NTI = nkeys / 64;
    __syncthreads();
    DMA_TILE(0); DMA_TILE(1); VM_WAIT(); __syncthreads();
    qkt(pA0, pA1, KSLOT(0), qr, r32, hi); partialSM(pA0, pA1, m_reg, mnA, alA);
    if (2 < NTI) DMA_TILE(2);
    for (int j = 1; j + 1 < NTI; j += 2) {
        qkt_negm(pB0, pB1, KSLOT(j), qr, -m_reg, r32, hi);
        finishSM(pA0, pA1, alA, l_reg, pa0, pa1, pa2, pa3);
        pv_d0(o, VSLOT(j - 1), pa0, pa1, pa2, pa3); partialSM_negm(pB0, pB1, m_reg, alB);
        VM_WAIT(); __syncthreads();
        if (j + 2 < NTI) DMA_TILE(j + 2);
        RESC(alB);
        qkt_negm(pA0, pA1, KSLOT(j + 1), qr, -m_reg, r32, hi);
        finishSM(pB0, pB1, alB, l_reg, pa0, pa1, pa2, pa3);
        pv_d0(o, VSLOT(j), pa0, pa1, pa2, pa3); partialSM_negm(pA0, pA1, m_reg, alA);
        VM_WAIT(); __syncthreads();
        if (j + 3 < NTI) DMA_TILE(j + 3);
        RESC(alA);
    }
    qkt_negm(pB0, pB1, KSLOT(NTI - 1), qr, -m_reg, r32, hi);
    finishSM(pA0, pA1, alA, l_reg, pa0, pa1, pa2, pa3);
    pv_d0(o, VSLOT(NTI - 2), pa0, pa1, pa2, pa3); partialSM_negm(pB0, pB1, m_reg, alB);
    RESC(alB);
    finishSM(pB0, pB1, alB, l_reg, pa0, pa1, pa2, pa3);
    pv_d0(o, VSLOT(NTI - 1), pa0, pa1, pa2, pa3);
    if (hi == 0) li_l[r32] = l_reg; asm volatile("s_waitcnt lgkmcnt(0)" ::: "memory");
#pragma unroll
    for (int r = 0; r < 16; ++r) { const float rl = __builtin_amdgcn_rcpf(li_l[crow(r, hi)]);
#pragma unroll
        for (int d0 = 0; d0 < 4; ++d0) o[d0][r] *= rl; }
    __syncthreads();
    int le = lane; asm volatile("" : "+v"(le));
    LAS unsigned char* wb = lds + wid * 16384;
    otile_write(wb, o, le & 31, le >> 5);
    asm volatile("s_waitcnt lgkmcnt(0)" ::: "memory");
    { const int rr0 = le >> 4, c8 = (le & 15) * 8; bf16* Ow = Ob + (size_t)(wid * 32 + rr0) * 2048 + c8; const LAS float* rp = (const LAS float*)wb + rr0 * 128 + c8;
#pragma unroll
      for (int it = 0; it < 8; ++it) { const f32x4 a = *(const LAS f32x4*)(rp + it * 512), b2 = *(const LAS f32x4*)(rp + it * 512 + 4);
          *(u32x4*)(Ow + (size_t)it * 4 * 2048) = pack8(a, b2); } }
#undef DMA_TILE
#undef KSLOT
#undef VSLOT
#undef RESC
}
}

namespace scan {
template <int D0, int KS> __device__ __forceinline__ void vfrag_issue(int vb, s16x4& l, s16x4& h) { l = tr_read<v_rd_off(D0, KS, 0)>(vb); h = tr_read<v_rd_off(D0, KS, 1)>(vb); }
using ::scan_vimg_kc;
__device__ __forceinline__ void vimg_kc(int tid, int (&kc)[2]) { scan_vimg_kc(tid, kc); }
__device__ __forceinline__ void dma_vimage(LAS unsigned char* lds, int img_off, const bf16* g, int ld, const int (&kc)[2], int wid) {
#pragma unroll
    for (int i = 0; i < 2; ++i) __builtin_amdgcn_global_load_lds((const unsigned*)(g + (size_t)(kc[i] >> 8) * ld + (kc[i] & 255)), (LAS unsigned*)(lds + img_off + (i * 8 + wid) * 1024), 16, 0, 0);
}
template <int DK> __device__ __forceinline__ void dma_ktile(LAS unsigned char* lds, int off, const bf16* g, int ld, int wid, int lane) {
    constexpr int KSTRB = DK * 2 + 16, NI = 64 * KSTRB / 1024;
    for (int j = wid; j < NI; j += 8) { const int o = j * 1024 + lane * 16; const int row = o / KSTRB; int ch = (o % KSTRB) >> 4; ch = (ch == DK / 8) ? 0 : ch;
        __builtin_amdgcn_global_load_lds((const unsigned*)(g + (size_t)row * ld + ch * 8), (LAS unsigned*)(lds + off + j * 1024), 16, 0, 0); }
}

template <bool SW> __device__ __forceinline__ void blk32_store(LAS unsigned char* stg, const f32x16& v, bf16* g, int ld, int lane) {
    const int r32 = lane & 31, hi = lane >> 5;
    LAS unsigned short* w = (LAS unsigned short*)(stg + (4 * hi) * 80 + r32 * 2);
#pragma unroll
    for (int r = 0; r < 16; r += 2) { const int ro = ((r & 3) + 8 * (r >> 2)) * 40;
        if (SW) { w[ro] = (unsigned short)f2bf_sw(v[r]); w[ro + 40] = (unsigned short)f2bf_sw(v[r + 1]); }
        else { const unsigned pk = cvtpk(v[r], v[r + 1]); w[ro] = (unsigned short)(pk & 0xffffu); w[ro + 40] = (unsigned short)(pk >> 16); } }
#pragma unroll
    for (int j = 0; j < 2; ++j) { const int idx = lane + 64 * j, row = idx >> 2, seg = idx & 3;
        const u32x4 o = *(const LAS u32x4*)(stg + row * 80 + seg * 16);
        *(GAS u32x4*)((GAS bf16*)g + (size_t)row * ld + seg * 8) = o; }
}
struct Src {
    const bf16* q0; const bf16* q1; const bf16* k0; const bf16* k1; const bf16* v; int ldq, ldk, ldv; size_t hsq, hsv  ; int H; bf16* ws; const float* egla; const float* rld;
};
__device__ __forceinline__ int chunk_of(int s, int dir) { return dir ? (NCH - 1 - s) : (s < 2 ? (NCH - 2 + s) : s - 2); }

template <int DK, int KS> __device__ __forceinline__ void a_step(f32x16* acc, int vbK, int vbV) {
    s16x4 bl, bh; vfrag_issue<0, KS>(vbV, bl, bh);
    s16x4 al[DK / 32], ah[DK / 32];
#pragma unroll
    for (int i = 0; i < DK / 32; ++i) { const int vbi = vbK + (i >> 2) * 16384; if ((i & 3) == 0) vfrag_issue<0, KS>(vbi, al[i], ah[i]); else if ((i & 3) == 1) vfrag_issue<1, KS>(vbi, al[i], ah[i]); else if ((i & 3) == 2) vfrag_issue<2, KS>(vbi, al[i], ah[i]); else vfrag_issue<3, KS>(vbi, al[i], ah[i]); }
    asm volatile("s_waitcnt lgkmcnt(0)" ::: "memory"); SBAR();
    const bf16x8 bfr = PK8(bl, bh);
#pragma unroll
    for (int i = 0; i < DK / 32; ++i) acc[i] = __builtin_amdgcn_mfma_f32_32x32x16_bf16(PK8(al[i], ah[i]), bfr, acc[i], 0, 0, 0);
}
template <int DK> __device__ __forceinline__ void phaseA(const Src& S, LAS unsigned char* lds, int G, int vcu) {
    const int tid = threadIdx.x, wid = __builtin_amdgcn_readfirstlane(tid >> 6), lane = tid & 63, r32 = lane & 31, hi = lane >> 5;
    constexpr int KH = DK / 128;
    constexpr int SLOT = (KH + 2) * 16384;
    static_assert(2 * SLOT <= SCR_BYTES, "scan phase A ring");
    int kc[2]; vimg_kc(tid, kc);
    const int nunits = NB * S.H * 2 * NCH;
    const int nmine = (nunits - vcu + G - 1) / G;
    const int nst = 2 * nmine;
    const int base = (int)(uintptr_t)lds + v_rd_base(lane);
#define A_DMA(g) do { const int g_ = (g); const int u_ = vcu + (g_ >> 1) * G, tt_ = g_ & 1; const int sq_ = u_ / NCH, cid_ = u_ % NCH, dir_ = sq_ & 1, bh_ = sq_ >> 1, b_ = bh_ / S.H, h_ = bh_ % S.H; \
        const size_t row_ = (size_t)b_ * SA + (size_t)cid_ * 128 + tt_ * 64; const bf16* kp_ = (dir_ ? S.k1 : S.k0) + row_ * S.ldk + h_ * S.hsq; const bf16* vp_ = S.v + row_ * S.ldv + h_ * S.hsv; const int so_ = (g_ & 1) * SLOT; \
        _Pragma("unroll") for (int im_ = 0; im_ < KH; ++im_) dma_vimage(lds, so_ + im_ * 16384, kp_ + im_ * 128, S.ldk, kc, wid); \
        _Pragma("unroll") for (int im_ = 0; im_ < 2; ++im_) dma_vimage(lds, so_ + (KH + im_) * 16384, vp_ + im_ * 128, S.ldv, kc, wid); } while (0)
    __syncthreads();
    if (nst > 0) A_DMA(0);
    f32x16 acc[DK / 32];
    for (int g = 0; g < nst; ++g) {
        VM_WAIT(); __syncthreads();
        if (g + 1 < nst) A_DMA(g + 1);
        const int tt = g & 1;
        if (tt == 0) {
#pragma unroll
            for (int i = 0; i < DK / 32; ++i) acc[i] = f32x16{}; }
        { int so = (g & 1) * SLOT; asm volatile("" : "+s"(so));
          const int vbK = base + so, vbV = base + so + (KH + (wid >> 2)) * 16384 + (wid & 3) * 512;
          a_step<DK, 0>(acc, vbK, vbV); a_step<DK, 1>(acc, vbK, vbV); a_step<DK, 2>(acc, vbK, vbV); a_step<DK, 3>(acc, vbK, vbV); }
        if (tt == 1) { const int u = vcu + (g >> 1) * G; const int sq = u / NCH, cid = u % NCH;
            bf16* Wp = S.ws + ((size_t)(sq * NCH + cid) * DK) * 256 + 32 * wid;
#pragma unroll
            for (int i = 0; i < DK / 32; ++i) blk32_store<true>(lds + 2 * SLOT + wid * 2560, acc[i], Wp + (size_t)(32 * i) * 256, 256, lane); }
    }
#undef A_DMA
}
template <int DK, bool RET, int PF = 4> __device__ __forceinline__ void phaseB(const Src& S, int G, int vcu, size_t dstoff = 0) {
    constexpr int NV = RET ? 2 : 1;
    const int nvec = NB * S.H * 2 * DK * 32; const int nthreads = G * NT; const int gt = vcu * NT + threadIdx.x;
    GAS bf16* base[NV]; const GAS float* ep[NV]; float eg[NV]; int dirv[NV]; bool on[NV];
#pragma unroll
    for (int q = 0; q < NV; ++q) { int v = gt + q * nthreads; on[q] = v < nvec; v = on[q] ? v : 0;
        const int sq = v / (DK * 32), rem = v % (DK * 32), i = rem >> 5, j8 = (rem & 31) * 8, dir = sq & 1, bh = sq >> 1, b = bh / S.H, h = bh % S.H;
        dirv[q] = dir; eg[q] = 1.f; if (RET) eg[q] = __expf(-__expf(S.rld[dir * 8 + h]) * 128.f);
        base[q] = (GAS bf16*)S.ws + ((size_t)sq * NCH * DK + i) * 256 + j8;
        ep[q] = RET ? nullptr : (const GAS float*)S.egla + ((size_t)(dir * 2 + b) * NCH) * 512 + h * 128 + i; }
    float st[NV][8]; u32x4 w[NV][PF]; float e[NV][PF];
#pragma unroll
    for (int q = 0; q < NV; ++q) {
#pragma unroll
        for (int j = 0; j < 8; ++j) st[q][j] = 0.f;
#pragma unroll
        for (int k = 0; k < PF; ++k) { const int c = chunk_of(k, dirv[q]); w[q][k] = on[q] ? *(const GAS u32x4*)(base[q] + (size_t)c * DK * 256) : (u32x4){0u, 0u, 0u, 0u}; e[q][k] = RET ? eg[q] : (on[q] ? ep[q][(size_t)c * 512] : 1.f); } }
    for (int s0 = 0; s0 < NCH; s0 += PF) {
#pragma unroll
        for (int k = 0; k < PF; ++k) { const int sidx = s0 + k;
            if (sidx < NCH) {
#pragma unroll
                for (int q = 0; q < NV; ++q) { const int c = chunk_of(sidx, dirv[q]);
                    u32x4 o;
#pragma unroll
                    for (int j = 0; j < 4; ++j) o[j] = cvtpk(st[q][2 * j], st[q][2 * j + 1]);
                    if (on[q]) *(GAS u32x4*)(base[q] + dstoff + (size_t)c * DK * 256) = o;
                    const float ee = e[q][k]; const u32x4 ww = w[q][k];
#pragma unroll
                    for (int j = 0; j < 4; ++j) { st[q][2 * j] = ee * (st[q][2 * j] + bflo(ww[j])); st[q][2 * j + 1] = ee * (st[q][2 * j + 1] + bfhi(ww[j])); }
                    if (sidx + PF < NCH) { const int cn = chunk_of(sidx + PF, dirv[q]); if (on[q]) { w[q][k] = *(const GAS u32x4*)(base[q] + (size_t)cn * DK * 256); if (!RET) e[q][k] = ep[q][(size_t)cn * 512]; } } } } }
    }
}
template <int OFF> __device__ __forceinline__ s16x4 tr_read_n(int vb) { s16x4 r; asm volatile("ds_read_b64_tr_b16 %0, %1 offset:%2" : "=&v"(r) : "v"(vb), "i"(OFF) : "memory"); return r; }
template <int KS> __device__ __forceinline__ void ab_step(f32x16& acc, int vbK, int vbV) {
    const s16x4 al = tr_read<v_rd_off(0, KS, 0)>(vbK), ah = tr_read<v_rd_off(0, KS, 1)>(vbK);
    const s16x4 bl = tr_read_n<KS * 2048>(vbV), bh = tr_read_n<KS * 2048 + 1024>(vbV);
    asm volatile("s_waitcnt lgkmcnt(0)" ::: "memory"); SBAR();
    acc = __builtin_amdgcn_mfma_f32_32x32x16_bf16(PK8(al, ah), PK8(bl, bh), acc, 0, 0, 0);
}
template <int DK, int MODE = 0> __device__ __forceinline__ void phaseAB(const Src& S, LAS unsigned char* lds, int G, int vcu) {
    static_assert(DK == 256, "fused carry pass: retention geometry");
    const int tid = threadIdx.x, wid = __builtin_amdgcn_readfirstlane(tid >> 6), lane = tid & 63, r32 = lane & 31, hi = lane >> 5, rb = wid >> 1, cb = wid & 1;
    constexpr int SLOT = 2 * 16384 + 2 * 8192;
    int kc[2]; vimg_kc(tid, kc);
    int vk[2];
#pragma unroll
    for (int i = 0; i < 2; ++i) { const int p = wid + 8 * i, tile = p >> 3, o = (p & 7) * 1024 + lane * 16; const int st = o >> 9, w = (o & 511) >> 1; const int kk = (st >> 1) * 8 + (w >> 5), c = (st & 1) * 32 + (w & 31);
        const int k = (kk & ~0xC) | ((kk & 4) << 1) | ((kk & 8) >> 1); vk[i] = (tile << 16) | (k << 8) | c; }
    const int base = (int)(uintptr_t)lds + v_rd_base(lane);
    const int ntasks = NB * S.H * 2 * 8;
    for (int task = vcu; task < ntasks; task += G) {
        const int sq = task >> 3, dkh = (task >> 2) & 1, dvq = task & 3, dir = sq & 1, bh = sq >> 1, b = bh / S.H, h = bh % S.H;
        const float eg = __expf(-__expf(S.rld[dir * 8 + h]) * 128.f);
        const bf16* kp = (dir ? S.k1 : S.k0) + (size_t)b * SA * S.ldk + h * S.hsq + dkh * 128; const bf16* vp = S.v + (size_t)b * SA * S.ldv + h * S.hsv + dvq * 64;
        bf16* sp = S.ws + ((size_t)sq * NCH * DK + dkh * 128 + 32 * rb) * 256 + dvq * 64 + 32 * cb;
#define AB_DMA(s_) do { const int c_ = chunk_of((s_), dir); const int so_ = ((s_) & 1) * SLOT; const size_t r0_ = (size_t)c_ * 128; \
        _Pragma("unroll") for (int tt_ = 0; tt_ < 2; ++tt_) dma_vimage(lds, so_ + tt_ * 16384, kp + (r0_ + tt_ * 64) * S.ldk, S.ldk, kc, wid); \
        _Pragma("unroll") for (int i_ = 0; i_ < 2; ++i_) __builtin_amdgcn_global_load_lds((const unsigned*)(vp + (r0_ + (vk[i_] >> 16) * 64 + ((vk[i_] >> 8) & 255)) * S.ldv + (vk[i_] & 255)), (LAS unsigned*)(lds + so_ + 32768 + (wid + 8 * i_) * 1024), 16, 0, 0); } while (0)
        f32x16 st = f32x16{};
        __syncthreads();
        AB_DMA(0);
        for (int s = 0; s < NCH; ++s) {
            if (s == 0) asm volatile("s_waitcnt vmcnt(0)" ::: "memory"); else asm volatile("s_waitcnt vmcnt(2)" ::: "memory");
            asm volatile("s_waitcnt lgkmcnt(0)" ::: "memory"); __builtin_amdgcn_s_barrier();
            if (!(MODE & 2)) { if (s + 1 < NCH) AB_DMA(s + 1); }
            const int c = chunk_of(s, dir);
            if (!(MODE & 1)) blk32_store<false>(lds + 2 * SLOT + wid * 2560, st, sp + (size_t)c * DK * 256, 256, lane);
            f32x16 acc = f32x16{};
            int so = (s & 1) * SLOT; asm volatile("" : "+s"(so));
#pragma unroll
            for (int tt = 0; tt < 2; ++tt) { const int vbK = base + so + tt * 16384 + rb * 512, vbV = base + so + 32768 + tt * 8192 + cb * 512;
                if (!(MODE & 4)) { ab_step<0>(acc, vbK, vbV); ab_step<1>(acc, vbK, vbV); ab_step<2>(acc, vbK, vbV); ab_step<3>(acc, vbK, vbV); } }
#pragma unroll
            for (int r = 0; r < 16; ++r) st[r] = eg * (st[r] + acc[r]);
        }
#undef AB_DMA
    }
}
template <int DK> __device__ __forceinline__ void qkt(f32x16& p0, f32x16& p1, const LAS unsigned char* Ks, const bf16x8* qr, int r32, int hi) {
    constexpr int KSTRB = DK * 2 + 16;
    p0 = f32x16{}; p1 = f32x16{};
#pragma unroll
    for (int d0 = 0; d0 < DK / 16; ++d0) { const int cb = (d0 * 16 + hi * 8) * 2;
        const bf16x8 b0 = *(const LAS bf16x8*)(Ks + r32 * KSTRB + cb);
        const bf16x8 b1 = *(const LAS bf16x8*)(Ks + (32 + r32) * KSTRB + cb);
        p0 = __builtin_amdgcn_mfma_f32_32x32x16_bf16(b0, qr[d0], p0, 0, 0, 0);
        p1 = __builtin_amdgcn_mfma_f32_32x32x16_bf16(b1, qr[d0], p1, 0, 0, 0); }
}
struct OutC { const bf16* gate; int ldg; const float* gain; bf16* mix; size_t hsg; };
template <int DK, bool RET, int MODE = 0> __device__ __forceinline__ void phaseC(const Src& S, const OutC& O, int nch_out, LAS unsigned char* lds, int G, int vcu) {
    const int tid = threadIdx.x, wid = __builtin_amdgcn_readfirstlane(tid >> 6), lane = tid & 63, r32 = lane & 31, hi = lane >> 5, qb = wid >> 1, dvh = wid & 1;
    constexpr int KSTRB = DK * 2 + 16, KT_BYTES = 64 * KSTRB, RED_OFF = 133120;
    constexpr bool EARLY = !RET;
    constexpr int SIMG = (DK / 64) * 2 * 16384, KT_OFF = EARLY ? SIMG : 0, VI_OFF = KT_OFF + 2 * KT_BYTES, VI2_OFF = EARLY ? 0 : VI_OFF + 32768;
    static_assert((EARLY ? VI_OFF + 32768 : VI_OFF + 65536) <= RED_OFF && SIMG <= RED_OFF && RED_OFF + 2048 <= SCR_BYTES, "scan phase C LDS map");
    int kc[2]; vimg_kc(tid, kc);
    const int nunits = NB * S.H * nch_out;
    const int lbase = (int)(uintptr_t)lds + v_rd_base(lane);
    bf16x8 qr[DK / 16];
#define PC_QLOAD(u_) do { const int cid_ = (u_) % nch_out, bh_ = (u_) / nch_out, b_ = bh_ / S.H, h_ = bh_ % S.H; \
        const GAS bf16* qp_ = (const GAS bf16*)S.q0 + ((size_t)b_ * SA + (size_t)cid_ * 128 + 32 * qb + r32) * S.ldq + h_ * S.hsq + hi * 8; \
        _Pragma("unroll") for (int d0 = 0; d0 < DK / 16; ++d0) qr[d0] = *(const GAS bf16x8*)(qp_ + d0 * 16); } while (0)
    if (vcu < nunits) PC_QLOAD(vcu);
    for (int u = vcu; u < nunits; u += G) {
        const int cid = u % nch_out, bh = u / nch_out, b = bh / S.H, h = bh % S.H;
        const size_t row0 = (size_t)b * SA + (size_t)cid * 128;
        const int tq = 32 * qb + r32;
        f32x16 o[4] = {};
#pragma unroll 1
        for (int dd = 0; dd < 2; ++dd) {
            const int dir = RET ? 1 - dd : dd;
            const int sq = bh * 2 + dir;
            const bool swapped = RET && dd == 1;
            const bf16* kp = ((dir && !RET) ? S.k1 : S.k0) + row0 * S.ldk + h * S.hsq; const bf16* vp = S.v + row0 * S.ldv + h * S.hsv;
#define PC_STATE() do { \
            __syncthreads(); \
            { const bf16* Sp = S.ws + ((size_t)(sq * NCH + cid) * DK) * 256; \
              _Pragma("unroll") for (int im = 0; im < (DK / 64) * 2; ++im) dma_vimage(lds, im * 16384, Sp + (size_t)(im >> 1) * 64 * 256 + (im & 1) * 128, 256, kc, wid); } \
            if (EARLY) { dma_ktile<DK>(lds, KT_OFF, kp, S.ldk, wid, lane); dma_ktile<DK>(lds, KT_OFF + KT_BYTES, kp + (size_t)64 * S.ldk, S.ldk, wid, lane); \
                _Pragma("unroll") for (int im = 0; im < 2; ++im) dma_vimage(lds, VI_OFF + im * 16384, vp + (size_t)(im & 1) * 128, S.ldv, kc, wid); } \
            if (!RET && dd == 1) { const bf16* qp = S.q1 + (row0 + tq) * S.ldq + h * S.hsq + hi * 8;     \
              _Pragma("unroll") for (int d0 = 0; d0 < DK / 16; ++d0) qr[d0] = *(const GAS bf16x8*)((const GAS bf16*)qp + d0 * 16); } \
            VM_WAIT(); __syncthreads(); \
            _Pragma("unroll") for (int tt = 0; tt < DK / 64; ++tt) pv_d0(o, lbase + (tt * 2 + dvh) * 16384, qr[4 * tt], qr[4 * tt + 1], qr[4 * tt + 2], qr[4 * tt + 3]); } while (0)
            if (!swapped) PC_STATE();
            if (!swapped) __syncthreads();
            if (swapped) {
            } else if (EARLY) {
#pragma unroll
                for (int im = 2; im < 4; ++im) dma_vimage(lds, VI2_OFF + (im - 2) * 16384, vp + (size_t)64 * S.ldv + (im & 1) * 128, S.ldv, kc, wid);
            } else {
              if (!(MODE & 2)) { dma_ktile<DK>(lds, KT_OFF, kp, S.ldk, wid, lane); dma_ktile<DK>(lds, KT_OFF + KT_BYTES, kp + (size_t)64 * S.ldk, S.ldk, wid, lane);
#pragma unroll
              for (int im = 0; im < 4; ++im) dma_vimage(lds, VI_OFF + im * 16384, vp + (size_t)(im >> 1) * 64 * S.ldv + (im & 1) * 128, S.ldv, kc, wid); }
              VM_WAIT(); __syncthreads(); }
#pragma unroll
            for (int kt = 0; kt < 2; ++kt) {
                const bool need = dir ? (64 * kt + 63 >= 32 * qb) : (64 * kt <= 32 * qb + 31);
                if (EARLY && kt == 1) { VM_WAIT(); __syncthreads(); }
                if (need) {
                    f32x16 p0, p1; qkt<DK>(p0, p1, lds + KT_OFF + kt * KT_BYTES, qr, r32, hi);
                    int tqv = tq - 4 * hi; asm volatile("" : "+v"(tqv));
                    if (RET && dd == 0) {
                        const float lf = -__expf(S.rld[h]) * 1.4426950408889634f, lb = -__expf(S.rld[8 + h]) * 1.4426950408889634f;
                        int hv = hi; asm volatile("" : "+v"(hv));
                        const float bb = lb + lf, a0 = (lf - 128.f * lb) + bb * (float)(64 * kt + 4 * hv);
#pragma unroll
                        for (int r = 0; r < 16; ++r) { const float ej = a0 + bb * (float)((r & 3) + 8 * (r >> 2));
                            p0[r] *= __builtin_amdgcn_exp2f(ej); p1[r] *= __builtin_amdgcn_exp2f(ej + 32.f * bb); } }
#pragma unroll
                    for (int r = 0; r < 16; ++r) { const int j0 = 64 * kt + (r & 3) + 8 * (r >> 2), j1 = j0 + 32;
                        const bool k0 = dir ? (j0 >= tqv) : (j0 <= tqv), k1 = dir ? (j1 >= tqv) : (j1 <= tqv);
                        p0[r] = k0 ? p0[r] : 0.f; p1[r] = k1 ? p1[r] : 0.f; }
                    bf16x8 pa0, pa1, pa2, pa3; PK4(p0, 0, pa0); PK4(p0, 8, pa1); PK4(p1, 0, pa2); PK4(p1, 8, pa3);
                    pv_d0(o, lbase + (kt == 0 ? VI_OFF : VI2_OFF) + dvh * 16384, pa0, pa1, pa2, pa3);
                }
            }
            if (swapped) PC_STATE();
            if (RET && dd == 0) {
                const float lf = -__expf(S.rld[h]) * 1.4426950408889634f, lb = -__expf(S.rld[8 + h]) * 1.4426950408889634f;
                int hv = hi; asm volatile("" : "+v"(hv));
                const float pp0 = (float)(32 * qb + 4 * hv); const float e0 = lb * (128.f - pp0) - lf * (pp0 + 1.f), de = -(lb + lf);
#pragma unroll
                for (int r = 0; r < 16; ++r) { const float sc_ = __builtin_amdgcn_exp2f(e0 + de * (float)((r & 3) + 8 * (r >> 2)));
#pragma unroll
                    for (int d = 0; d < 4; ++d) o[d][r] *= sc_; } }
        }
        LAS f32x2* red = (LAS f32x2*)(lds + RED_OFF);
        u32x4 gpre[8];
        { int ln = lane; asm volatile("" : "+v"(ln)); const int rr0 = ln >> 4, c8 = (ln & 15) * 8;
          const GAS bf16* gp = (const GAS bf16*)O.gate + (row0 + 32 * qb + rr0) * O.ldg + h * O.hsg + dvh * 128 + c8;
#pragma unroll
          for (int it = 0; it < 8; ++it) gpre[it] = *(const GAS u32x4*)(gp + (size_t)it * 4 * O.ldg); }
        if (u + G < nunits) PC_QLOAD(u + G);
#pragma unroll
        for (int r = 0; r < 16; ++r) { float a = 0.f, q2 = 0.f;
#pragma unroll
            for (int d = 0; d < 4; ++d) { a += o[d][r]; q2 += o[d][r] * o[d][r]; }
#pragma unroll
            for (int m = 1; m < 32; m <<= 1) { a += __shfl_xor(a, m); q2 += __shfl_xor(q2, m); }
            if (r32 == 0) red[wid * 32 + crow(r, hi)] = (f32x2){a, q2}; }
        __syncthreads();
        { float gv[4];
#pragma unroll
          for (int d = 0; d < 4; ++d) gv[d] = O.gain[dvh * 128 + 32 * d + r32];
#pragma unroll
          for (int r = 0; r < 16; ++r) { const int rw = crow(r, hi); const f32x2 pa_ = red[wid * 32 + rw], pb_ = red[(wid ^ 1) * 32 + rw];
              const float t1 = pa_.x + pb_.x, t2 = pa_.y + pb_.y; float mean, rstd;
              if (RET) { mean = t1 * (1.f / 256.f); rstd = rsqrtf(fmaxf(t2 * (1.f / 256.f) - mean * mean, 0.f) + EPS); } else { mean = 0.f; rstd = rsqrtf(t2 * (1.f / 256.f) + EPS); }
#pragma unroll
              for (int d = 0; d < 4; ++d) o[d][r] = (o[d][r] - mean) * rstd * gv[d]; } }
        LAS unsigned char* wb = lds + wid * 16384;
        otile_write(wb, o, r32, hi);
        asm volatile("s_waitcnt lgkmcnt(0)" ::: "memory");
        { int ln = lane; asm volatile("" : "+v"(ln));
          const int rr0 = ln >> 4, c8 = (ln & 15) * 8; const size_t row = row0 + 32 * qb + rr0;
          GAS bf16* mp = (GAS bf16*)O.mix + row * 2048 + h * 256 + dvh * 128 + c8; const LAS float* rp = (const LAS float*)wb + rr0 * 128 + c8;
#pragma unroll
          for (int it = 0; it < 8; ++it) { f32x4 a = *(const LAS f32x4*)(rp + it * 512), b2 = *(const LAS f32x4*)(rp + it * 512 + 4);
              const u32x4 g = gpre[it];
              a[0] *= silu_f(bflo(g.x)); a[1] *= silu_f(bfhi(g.x)); a[2] *= silu_f(bflo(g.y)); a[3] *= silu_f(bfhi(g.y)); b2[0] *= silu_f(bflo(g.z)); b2[1] *= silu_f(bfhi(g.z)); b2[2] *= silu_f(bflo(g.w)); b2[3] *= silu_f(bfhi(g.w));
              *(GAS u32x4*)(mp + (size_t)it * 4 * 2048) = pack8(a, b2); } }
    }
#undef PC_QLOAD
#undef PC_STATE
}
}

struct Args { const float* in[29]; float* out; unsigned char* ws; int ph_lo, ph_hi; };
struct Frame {
    LAS unsigned char* lds; volatile LAS unsigned* MISC; unsigned* ctl;
    int tid, lane, wave, vcu, G;
    const float* const* in; float* out; unsigned char* ws;
};
enum { I_X = 0, I_C, I_CTX, I_CCTX, I_ADAW, I_ADAB, I_NMIX, I_NFFN, I_NFIN, I_EVWIN, I_GLAW2, I_GLAB2, I_GLAN, I_MQN, I_WUQ, I_MKVN, I_WUKV, I_EVWOUT, I_FFNG, I_FFNU, I_FFND,
       I_ODWIN, I_RLD, I_RETN, I_ODWOUT, I_ROUTER, I_MOEG, I_MOEU, I_MOED };

struct MapId { int off; __device__ __forceinline__ int operator()(int n) const { return off + n; } };
struct MapGU { int up; __device__ __forceinline__ int operator()(int n) const { return (n >> 7) * 256 + up * 128 + (n & 127); } };
struct MapIn0 { __device__ __forceinline__ int operator()(int n) const {
    if (n < 3072) return n; if (n < 3088) return C_GAF + (n - 3072); if (n < 3104) return C_GAB + (n - 3088); if (n < 3872) return C_MQ + (n - 3104); if (n < 4384) return C_MKV + (n - 3872); return C_MKR + (n - 4384); } };
template <class RM> __device__ __forceinline__ void transpose_item(const float* W, int K, int N, bf16* WT, const RM& rm, LAS float* scr, int item, int lane) {
    const int nblk = N / 32, kb = item / nblk, nb = item % nblk, k0 = 64 * kb, n0 = 32 * nb;
#pragma unroll 8
    for (int i = 0; i < 32; ++i) { const int kk = 2 * i + (lane >> 5); scr[kk * 33 + (lane & 31)] = W[(size_t)(k0 + kk) * N + n0 + (lane & 31)]; }
    LDS_WAIT(); asm volatile("" ::: "memory");
    const int c = lane & 7;
#pragma unroll
    for (int j = 0; j < 4; ++j) { const int n = (lane >> 3) + 8 * j; const LAS float* s = scr + (8 * c) * 33 + n;
        u32x4 o; o.x = cvtpk(s[0 * 33], s[1 * 33]); o.y = cvtpk(s[2 * 33], s[3 * 33]); o.z = cvtpk(s[4 * 33], s[5 * 33]); o.w = cvtpk(s[6 * 33], s[7 * 33]);
        *(u32x4*)(WT + (size_t)rm(n0 + n) * K + k0 + 8 * c) = o; }
    LDS_WAIT(); asm volatile("" ::: "memory");
}
template <class RM> __device__ __forceinline__ void transpose_item8(const float* W, int K, int N, unsigned char* WT, const RM& rm, LAS float* scr, int item, int lane) {
    const int nblk = N / 32, kb = item / nblk, nb = item % nblk, k0 = 64 * kb, n0 = 32 * nb;
#pragma unroll 8
    for (int i = 0; i < 32; ++i) { const int kk = 2 * i + (lane >> 5); scr[kk * 33 + (lane & 31)] = W[(size_t)(k0 + kk) * N + n0 + (lane & 31)]; }
    LDS_WAIT(); asm volatile("" ::: "memory");
    const int c = lane & 7;
#pragma unroll
    for (int j = 0; j < 4; ++j) { const int n = (lane >> 3) + 8 * j; const LAS float* s = scr + (8 * c) * 33 + n;
        u32x2 o; o.x = pack4_fp8(s[0 * 33] * W8_SCALE, s[1 * 33] * W8_SCALE, s[2 * 33] * W8_SCALE, s[3 * 33] * W8_SCALE); o.y = pack4_fp8(s[4 * 33] * W8_SCALE, s[5 * 33] * W8_SCALE, s[6 * 33] * W8_SCALE, s[7 * 33] * W8_SCALE);
        *(u32x2*)(WT + (size_t)rm(n0 + n) * K + k0 + 8 * c) = o; }
    LDS_WAIT(); asm volatile("" ::: "memory");
}
__device__ __forceinline__ void sincos_acc(float af, float& s, float& c) {
    const double a = (double)af; const double n = rint(a * 0.63661977236758134308); const double r = (a - n * 1.57079632679489655800) - n * 6.12323399573676603587e-17;
    const double r2 = r * r;
    double sp = 1.0 / 6227020800.0; sp = sp * r2 - 1.0 / 39916800.0; sp = sp * r2 + 1.0 / 362880.0; sp = sp * r2 - 1.0 / 5040.0; sp = sp * r2 + 1.0 / 120.0; sp = sp * r2 - 1.0 / 6.0; sp = sp * r2 + 1.0; sp *= r;
    double cp = 1.0 / 479001600.0; cp = cp * r2 - 1.0 / 3628800.0; cp = cp * r2 + 1.0 / 40320.0; cp = cp * r2 - 1.0 / 720.0; cp = cp * r2 + 1.0 / 24.0; cp = cp * r2 - 0.5; cp = cp * r2 + 1.0;
    const int q = ((int)n) & 3; double ss, cc;
    if (q == 0) { ss = sp; cc = cp; } else if (q == 1) { ss = cp; cc = -sp; } else if (q == 2) { ss = -sp; cc = -cp; } else { ss = -cp; cc = sp; }
    s = (float)ss; c = (float)cc;
}

__device__ __forceinline__ void p_ffn_copies(Frame& F, int vb0) {
    if (F.vcu < vb0) return;
    LAS float* scr = (LAS float*)(F.lds + F.wave * 16384);
    const int gw = (F.vcu - vb0) * NWAVES + F.wave, NGW = (F.G - vb0) * NWAVES;
    unsigned char* ws = F.ws;
    constexpr int I4 = 32 * 176, I6 = 88 * 64;
    for (int it = gw; it < 2 * I4 + I6; it += NGW) {
        if (it < I4) transpose_item(F.in[I_FFNG], 2048, 5632, (bf16*)(ws + WS_W_GU), MapGU{0}, scr, it, F.lane);
        else if (it < 2 * I4) transpose_item(F.in[I_FFNU], 2048, 5632, (bf16*)(ws + WS_W_GU), MapGU{1}, scr, it - I4, F.lane);
        else transpose_item8(F.in[I_FFND], 5632, 2048, ws + WS_W_DN, MapId{0}, scr, it - 2 * I4, F.lane); }
}

__device__ __forceinline__ void p_prologue(Frame& F) {
    LAS float* scr = (LAS float*)(F.lds + F.wave * 16384);
    const int gw = F.vcu * NWAVES + F.wave, NGW = F.G * NWAVES;
    unsigned char* ws = F.ws;
    constexpr int I0 = 32 * 139, I1 = 12 * 48, I2 = 8 * 64, I3 = 32 * 64, I4 = 32 * 176, I5 = I4, I6 = 88 * 64, I7 = 32 * 256, I8 = 32 * 64;
    constexpr int NITEMS = I0 + I1 + I2 + I3 + I7 + I8;
    for (int it = gw; it < NITEMS; it += NGW) {
        int r = it; if (r >= I0 + I1 + I2 + I3) r += I4 + I5 + I6;
        if (r < I0) { transpose_item(F.in[I_EVWIN], 2048, 4448, (bf16*)(ws + WS_W_IN0), MapIn0{}, scr, r, F.lane); continue; } r -= I0;
        if (r < I1) { transpose_item(F.in[I_WUQ], 768, 1536, (bf16*)(ws + WS_W_UQ), MapId{0}, scr, r, F.lane); continue; } r -= I1;
        if (r < I2) { transpose_item(F.in[I_WUKV], 512, 2048, (bf16*)(ws + WS_W_UKV), MapId{0}, scr, r, F.lane); continue; } r -= I2;
        if (r < I3) { transpose_item(F.in[I_EVWOUT], 2048, 2048, (bf16*)(ws + WS_W_OUT0), MapId{0}, scr, r, F.lane); continue; } r -= I3;
        if (r < I4) { transpose_item(F.in[I_FFNG], 2048, 5632, (bf16*)(ws + WS_W_GU), MapGU{0}, scr, r, F.lane); continue; } r -= I4;
        if (r < I5) { transpose_item(F.in[I_FFNU], 2048, 5632, (bf16*)(ws + WS_W_GU), MapGU{1}, scr, r, F.lane); continue; } r -= I5;
        if (r < I6) { transpose_item8(F.in[I_FFND], 5632, 2048, ws + WS_W_DN, MapId{0}, scr, r, F.lane); continue; } r -= I6;
        if (r < I7) { transpose_item(F.in[I_ODWIN], 2048, 8192, (bf16*)(ws + WS_W_IN1), MapId{0}, scr, r, F.lane); continue; } r -= I7;
        transpose_item(F.in[I_ODWOUT], 2048, 2048, (bf16*)(ws + WS_W_OUT1), MapId{0}, scr, r, F.lane);
    }
    { u32x4* z = (u32x4*)((bf16*)(ws + WS_W_IN0) + (size_t)4448 * 2048); const int n16 = 160 * 2048 * 2 / 16;
      for (int i = F.vcu * NT + F.tid; i < n16; i += F.G * NT) z[i] = (u32x4){0u, 0u, 0u, 0u}; }
    { float* cm = (float*)(ws + WS_ROPE_M); float* cr = (float*)(ws + WS_ROPE_R);
      for (int i = F.vcu * NT + F.tid; i < ROPE_M_N + ROPE_R_N; i += F.G * NT) { const bool m = i < ROPE_M_N; const int half = m ? 16 : 64, j = m ? i : i - ROPE_M_N;
          const int pi = j / half, f = j % half; const float pos = (float)(pi < 256 ? pi : pi - 256);
          const float inv = 1.0f / powf(10000.0f, (float)(2 * f) / (float)(2 * half)); float sn, cs; sincos_acc(pos * inv, sn, cs);
          if (m) { cm[j] = cs; cm[ROPE_M_N + j] = sn; } else { cr[j] = cs; cr[ROPE_R_N + j] = sn; } } }
    __syncthreads();
    { LAS float* sc = (LAS float*)F.lds; LAS float* red = (LAS float*)(F.lds + 24576);
      for (int i = F.tid; i < 3 * 2048; i += NT) { const int s = i / 2048, k = i % 2048; const float v = (s < 2) ? F.in[I_C][s * 2048 + k] : F.in[I_CCTX][k]; sc[i] = silu_f(v); }
      __syncthreads();
      const int ks = F.tid >> 3, l8 = F.tid & 7;
      for (int it = F.vcu; it < 2 * 384; it += F.G) { const int l = it / 384, cg = it % 384; const int col = cg * 32 + 4 * l8;
          const GAS float* wp = (const GAS float*)F.in[I_ADAW] + (size_t)l * 2048 * 12288 + (size_t)(ks * 32) * 12288 + col;
          f32x4 a0 = {0.f, 0.f, 0.f, 0.f}, a1 = a0, a2 = a0;
#pragma unroll 16
          for (int k = 0; k < 32; ++k) { const f32x4 w = *(const GAS f32x4*)(wp + (size_t)k * 12288); const int kk = ks * 32 + k; a0 += w * sc[kk]; a1 += w * sc[2048 + kk]; a2 += w * sc[4096 + kk]; }
          LAS float* rp = red + (ks * 8 + l8) * 12;
          rp[0] = a0[0]; rp[1] = a0[1]; rp[2] = a0[2]; rp[3] = a0[3]; rp[4] = a1[0]; rp[5] = a1[1]; rp[6] = a1[2]; rp[7] = a1[3]; rp[8] = a2[0]; rp[9] = a2[1]; rp[10] = a2[2]; rp[11] = a2[3];
          __syncthreads();
          if (F.tid < 96) { const int s = F.tid / 32, c = F.tid % 32; float acc = 0.f;
              for (int q = 0; q < 64; ++q) acc += red[(q * 8 + (c >> 2)) * 12 + s * 4 + (c & 3)];
              const int n = cg * 32 + c; ((float*)(ws + WS_MOD))[((size_t)l * 3 + s) * 12288 + n] = acc + F.in[I_ADAB][l * 12288 + n]; }
          __syncthreads(); } }
}
struct MapSel { int gu, up; __device__ __forceinline__ int operator()(int n) const { return gu ? (n >> 7) * 256 + up * 128 + (n & 127) : n; } };
__device__ __forceinline__ void conv_round(Frame& F, int g) {
    LAS float* scr = (LAS float*)(F.lds + F.wave * 16384);
    const int kind = g >> 24, item = (g & 0xffffff) * 8 + F.wave;
    const float* W; unsigned char* WT; int K, N, r; MapSel rm;
    if (kind == 0) { const int e = item / (2 * 5632), q = item % (2 * 5632); const int up = q >= 5632 ? 1 : 0; r = q - up * 5632;
        W = F.in[up ? I_MOEU : I_MOEG] + (size_t)e * 2048 * 5632; WT = F.ws + WS_WMOE + (size_t)e * 11264 * 2048; K = 2048; N = 5632; rm = MapSel{1, up}; }
    else { const int e = item / 5632; r = item % 5632; W = F.in[I_MOED] + (size_t)e * 5632 * 2048; WT = F.ws + WS_WMOE_DN + (size_t)e * 2048 * 5632; K = 5632; N = 2048; rm = MapSel{0, 0}; }
    transpose_item8(W, K, N, WT, rm, scr, r, F.lane);
}
__device__ __forceinline__ int conv_grab(unsigned* ctl, unsigned x, bool allow_dn) {
    unsigned* q = ctl + CW_CQ + 64 * x;
    if (xb_ld(q) < (unsigned)CQ_GU_ROUNDS) { const unsigned r = xb_add(q, 1u); if (r < (unsigned)CQ_GU_ROUNDS) return (int)(x * CQ_GU_ROUNDS + r); }
    if (allow_dn) { unsigned* qd = q + 1024; if (xb_ld(qd) < (unsigned)CQ_DN_ROUNDS) { const unsigned r = xb_add(qd, 1u); if (r < (unsigned)CQ_DN_ROUNDS) return (1 << 24) | (int)(x * CQ_DN_ROUNDS + r); } }
    return -1;
}
__device__ __forceinline__ void xcd_barrier_fill(const XcdBarrier& b, Frame& F, bool allow_dn) {
    asm volatile("s_waitcnt vmcnt(0)" ::: "memory");
    __syncthreads();
    volatile LAS unsigned* st = b.st;
    if (threadIdx.x == 0) {
        unsigned* bar = b.bar;
        __builtin_amdgcn_s_waitcnt(0);
        unsigned nloc = st[0], nx = st[1];
        if (nloc == 0u) { xcd_barrier_complete(bar, b.x, nloc, nx); st[0] = nloc; st[1] = nx; }
        const unsigned old = xb_add(&bar[XB_XSUB(b.x)], 1u);
        const unsigned gen = old / nloc;
        if (old + 1u == (gen + 1u) * nloc) {
            __builtin_amdgcn_fence(__ATOMIC_RELEASE, "agent");
            asm volatile("s_waitcnt vmcnt(0)" ::: "memory");
            const unsigned og = xb_add(&bar[XB_TOP], 1u);
            const unsigned tg = og / nx;
            if (og + 1u == (tg + 1u) * nx) xb_add(&bar[XB_TOPGEN], 1u);
            else XB_SPIN_TIGHT(xb_ld(&bar[XB_TOPGEN]) == tg, bar);
            __builtin_amdgcn_fence(__ATOMIC_ACQUIRE, "agent");
            xb_add(&bar[XB_XGEN(b.x)], 1u);
            asm volatile("s_waitcnt vmcnt(0)" ::: "memory");
            st[2] = 0u;
        } else { st[2] = 1u; st[3] = gen; }
    }
    __syncthreads();
    if (st[2]) {
        for (;;) {
            if (threadIdx.x == 0) { unsigned* bar = b.bar; const unsigned gen = st[3]; int g = -2;
                if (xb_ld(&bar[XB_XGEN(b.x)]) == gen) { g = conv_grab(F.ctl, b.x & 7u, allow_dn);
                    if (g < 0) { XB_SPIN(xb_ld(&bar[XB_XGEN(b.x)]) == gen, bar); g = -2; } }
                st[4] = (unsigned)g; }
            __syncthreads();
            const int g = (int)st[4];
            if (g == -2) break;
            conv_round(F, g);
            __syncthreads();
        }
        if (threadIdx.x == 0) { __builtin_amdgcn_fence(__ATOMIC_ACQUIRE, "agent"); asm volatile("s_waitcnt vmcnt(0)" ::: "memory"); }
    }
    __syncthreads();
}
__device__ __forceinline__ void p_conv_drain(Frame& F, unsigned x) {
    volatile LAS unsigned* st = F.MISC + 16;
    __syncthreads();
    for (;;) {
        if (threadIdx.x == 0) { int g = -1;
            for (unsigned j = 0; j < 8u && g < 0; ++j) g = conv_grab(F.ctl, (x + j) & 7u, true);
            st[0] = (unsigned)g; }
        __syncthreads();
        const int g = (int)st[0];
        if (g < 0) break;
        conv_round(F, g);
        __syncthreads();
    }
}

template <bool ROUTER, bool OUT8 = false> __device__ __forceinline__ void p_norm(Frame& F, int layer, int ffn, bool latent_only, const float* srcLat, const float* srcCtx) {
    const int gw = F.vcu * NWAVES + F.wave, NGW = F.G * NWAVES;
    const int nrows = latent_only ? MLAT : MALL; const int rpw = (nrows + NGW - 1) / NGW;
    const float* gain = F.in[ffn ? I_NFFN : I_NMIX] + layer * 2048; const float* mod = (const float*)(F.ws + WS_MOD) + (size_t)layer * 3 * 12288;
    bf16* H = (bf16*)(F.ws + WS_H);
    LAS float* wr_l = (LAS float*)F.lds;
    if (ROUTER) { __syncthreads(); const float* wr = F.in[I_ROUTER];
        for (int i = F.tid; i < 2048 * 8; i += NT) { const int col = i >> 3, e = i & 7; wr_l[e * 2048 + col] = wr[i]; }
        __syncthreads(); }
    f32x4 A[8], Bv[8]; int curset = -1;
    const int r_lo = gw * rpw, r_hi = (r_lo + rpw < nrows) ? r_lo + rpw : nrows;
    auto rowsrc = [&](int r) -> const float* { int b, t; if (latent_only) { b = r / T; t = r % T; } else { b = r / SA; t = r % SA; }
        return (t >= T) ? srcCtx + ((size_t)b * CTX + (t - T)) * D : srcLat + ((size_t)b * T + t) * D; };
    f32x4 v[8];
    if (r_lo < r_hi) { const float* x0 = rowsrc(r_lo);
#pragma unroll
        for (int j = 0; j < 8; ++j) v[j] = *(const f32x4*)(x0 + 4 * F.lane + 256 * j); }
    for (int r = r_lo; r < r_hi; ++r) {
        int b, t; if (latent_only) { b = r / T; t = r % T; } else { b = r / SA; t = r % SA; }
        const bool isctx = t >= T; const int set = isctx ? 2 : b;
        f32x4 vn[8];
        { const float* xn = rowsrc((r + 1 < r_hi) ? r + 1 : r);
#pragma unroll
          for (int j = 0; j < 8; ++j) vn[j] = *(const f32x4*)(xn + 4 * F.lane + 256 * j); }
        if (set != curset) { curset = set; const float* sh = mod + (size_t)set * 12288 + (ffn ? 3 : 0) * 2048; const float* scv = sh + 2048;
#pragma unroll
            for (int j = 0; j < 8; ++j) { const int col = 4 * F.lane + 256 * j; const f32x4 g = *(const f32x4*)(gain + col), s = *(const f32x4*)(scv + col); A[j] = g * (s + 1.0f); Bv[j] = *(const f32x4*)(sh + col); } }
        float ss = 0.f;
#pragma unroll
        for (int j = 0; j < 8; ++j) ss += (v[j][0] * v[j][0] + v[j][1] * v[j][1]) + (v[j][2] * v[j][2] + v[j][3] * v[j][3]);
        const float rs = rsqrtf(wave_sum(ss) * (1.f / D) + EPS);
        const size_t urow = (size_t)b * SA + t;
        if constexpr (OUT8) { unsigned* o4 = (unsigned*)(F.ws + WS_H8 + urow * D) + F.lane;
#pragma unroll
            for (int j = 0; j < 8; ++j) { v[j] = v[j] * rs * A[j] + Bv[j]; o4[64 * j] = pack4_fp8(v[j][0], v[j][1], v[j][2], v[j][3]); }
        } else { u32x2* o8 = (u32x2*)(H + urow * D) + F.lane;
#pragma unroll
            for (int j = 0; j < 8; ++j) { v[j] = v[j] * rs * A[j] + Bv[j]; u32x2 w; w.x = cvtpk(v[j][0], v[j][1]); w.y = cvtpk(v[j][2], v[j][3]); o8[64 * j] = w; } }
        if (ROUTER) {
            float lg[8];
#pragma unroll
            for (int e = 0; e < 8; ++e) { float a = 0.f;
#pragma unroll
                for (int j = 0; j < 8; ++j) { const f32x4 w = *(const LAS f32x4*)(wr_l + e * 2048 + 4 * F.lane + 256 * j); a += (v[j][0] * w[0] + v[j][1] * w[1]) + (v[j][2] * w[2] + v[j][3] * w[3]); }
                lg[e] = wave_sum(a); }
            if (F.lane == 0) { int i0 = 0; float v0 = lg[0];
#pragma unroll
                for (int e = 1; e < 8; ++e) if (lg[e] > v0) { v0 = lg[e]; i0 = e; }
                int i1 = -1; float v1 = -3.0e38f;
#pragma unroll
                for (int e = 0; e < 8; ++e) if (e != i0 && lg[e] > v1) { v1 = lg[e]; i1 = e; }
                const float w1 = 1.f / (1.f + __expf(v0 - v1)), w0 = 1.f - w1;
                int* topi = (int*)(F.ws + WS_TOPI); float* topw = (float*)(F.ws + WS_TOPI + 262144); int* pos = (int*)(F.ws + WS_TOPI + 524288);
                topi[2 * r] = i0; topi[2 * r + 1] = i1; topw[2 * r] = w0; topw[2 * r + 1] = w1;
                pos[2 * r] = (int)__hip_atomic_fetch_add(F.ctl + CW_MOE + 64 * i0, 1u, RLX_AGENT); pos[2 * r + 1] = (int)__hip_atomic_fetch_add(F.ctl + CW_MOE + 64 * i1, 1u, RLX_AGENT); }
        }
#pragma unroll
        for (int j = 0; j < 8; ++j) v[j] = vn[j];
    }
}

__device__ __forceinline__ void p_prep0(Frame& F) {
    const int gw = F.vcu * NWAVES + F.wave, NGW = F.G * NWAVES;
    const bf16* P0 = (const bf16*)(F.ws + WS_P0);
    bf16* QL = (bf16*)(F.ws + WS_QLAT); bf16* KVL = (bf16*)(F.ws + WS_KVLAT); bf16* KR = (bf16*)(F.ws + WS_KR);
    const float* cm = (const float*)(F.ws + WS_ROPE_M); const float* sm = cm + ROPE_M_N;
    const float* qn = F.in[I_MQN]; const float* kvn = F.in[I_MKVN];
    float qg[12]; f32x4 kg0, kg1;
#pragma unroll
    for (int j = 0; j < 12; ++j) qg[j] = qn[12 * F.lane + j];
    kg0 = *(const f32x4*)(kvn + 8 * F.lane); kg1 = *(const f32x4*)(kvn + 8 * F.lane + 4);
    u32x2 na, nb2, nc2; u32x4 nkv; unsigned short nkr;
#define PREP_LOAD(r_) do { const GAS bf16* pr_ = (const GAS bf16*)P0 + (size_t)(r_) * N0; const GAS u32x2* p_ = (const GAS u32x2*)(pr_ + C_MQ + 12 * F.lane); na = p_[0]; nb2 = p_[1]; nc2 = p_[2]; \
        nkv = *(const GAS u32x4*)(pr_ + C_MKV + 8 * F.lane); nkr = pr_[C_MKR + F.lane]; } while (0)
    const int nex = (NB * NCH * 2) % F.G; const int gwm = (F.vcu - nex) * NWAVES + F.wave, NGWm = (F.G - nex) * NWAVES;
    if (F.vcu >= nex && gwm < MALL) PREP_LOAD(gwm);
    if (F.vcu >= nex) for (int r = gwm; r < MALL; r += NGWm) {
        const int t = r % SA;
        const u32x2 a = na, b2 = nb2, c2 = nc2; const u32x4 akv = nkv; const unsigned short akr = nkr;
        { const int rn = (r + NGWm < MALL) ? r + NGWm : r; PREP_LOAD(rn); }
        { float v[12] = {bflo(a.x), bfhi(a.x), bflo(a.y), bfhi(a.y), bflo(b2.x), bfhi(b2.x), bflo(b2.y), bfhi(b2.y), bflo(c2.x), bfhi(c2.x), bflo(c2.y), bfhi(c2.y)};
          float ss = 0.f;
#pragma unroll
          for (int j = 0; j < 12; ++j) ss += v[j] * v[j];
          const float rs = rsqrtf(wave_sum(ss) * (1.f / 768.f) + EPS);
          GAS u32x2* o = (GAS u32x2*)((GAS bf16*)QL + (size_t)r * 768 + 12 * F.lane);
#pragma unroll
          for (int j = 0; j < 3; ++j) { u32x2 w; w.x = cvtpk(v[4 * j] * rs * qg[4 * j], v[4 * j + 1] * rs * qg[4 * j + 1]); w.y = cvtpk(v[4 * j + 2] * rs * qg[4 * j + 2], v[4 * j + 3] * rs * qg[4 * j + 3]); o[j] = w; } }
        { const u32x4 a4 = akv; float v[8] = {bflo(a4.x), bfhi(a4.x), bflo(a4.y), bfhi(a4.y), bflo(a4.z), bfhi(a4.z), bflo(a4.w), bfhi(a4.w)};
          float ss = 0.f;
#pragma unroll
          for (int j = 0; j < 8; ++j) ss += v[j] * v[j];
          const float rs = rsqrtf(wave_sum(ss) * (1.f / 512.f) + EPS);
          u32x4 w; w.x = cvtpk(v[0] * rs * kg0[0], v[1] * rs * kg0[1]); w.y = cvtpk(v[2] * rs * kg0[2], v[3] * rs * kg0[3]); w.z = cvtpk(v[4] * rs * kg1[0], v[5] * rs * kg1[1]); w.w = cvtpk(v[6] * rs * kg1[2], v[7] * rs * kg1[3]);
          *(GAS u32x4*)((GAS bf16*)KVL + (size_t)r * 512 + 8 * F.lane) = w; }
        { float x = bf2f(akr); const float xo = __shfl_xor(x, 1);
          if (t < T) { const int ri = F.lane >> 1, ro = ((ri & 16) ? 256 + (t & 63) : (t >> 6)) * 16 + (ri & 15); const float c = ((const GAS float*)cm)[ro], s = ((const GAS float*)sm)[ro]; x = (F.lane & 1) ? (xo * s + x * c) : (x * c - xo * s); }
          ((GAS bf16*)KR)[(size_t)r * 64 + F.lane] = f2bf(x); }
    }
#undef PREP_LOAD
    __syncthreads();
    { LAS unsigned char* lds = F.lds; LAS float* ga = (LAS float*)lds;
      constexpr int INB = 16384, OUTB = 49152;
      const int dir0 = __builtin_amdgcn_readfirstlane(F.tid >> 8); const float* w2 = F.in[I_GLAW2]; const float* b2 = F.in[I_GLAB2];
      const int wid = F.wave;
      float* GE = (float*)(F.ws + WS_GE);
      const float qs = 0.08838834764831845f;
      for (int u = F.vcu; u < NB * NCH * 2; u += F.G) { const int half = u & 1, bc = u >> 1, b = bc / NCH, cid = bc % NCH; const size_t row0 = (size_t)b * SA + (size_t)cid * 128;
          int chl = F.tid & 255; asm volatile("" : "+v"(chl));
          int dir = dir0; asm volatile("" : "+s"(dir));
          const int ch = chl + 256 * half;
          float wv[16];
#pragma unroll
          for (int q = 0; q < 16; ++q) wv[q] = w2[dir * 16 * 512 + q * 512 + ch];
          const float bias = b2[dir * 512 + ch];
          const int pqk = (F.tid >> 8) & 1, ptk = (F.tid >> 5) & 7, pc8 = (F.tid & 31) * 8;
          const GAS bf16* src0 = (const GAS bf16*)P0 + (row0 + ptk) * N0 + (pqk ? C_GK : C_GQ) + half * 256 + pc8;
#define GLA_TB(d_, it_) ((d_) ? 120 - 8 * (it_) : 8 * (it_))
#define GLA_DMA(it_) do { _Pragma("unroll") for (int i_ = 0; i_ < 2; ++i_) __builtin_amdgcn_global_load_lds((const unsigned*)(src0 + (size_t)GLA_TB(i_, it_) * N0), \
              (LAS unsigned*)(lds + INB + ((it_) & 1) * 16384 + (i_ * 512 + wid * 64) * 16), 16, 0, 0); } while (0)
#define GLA_FLUSH(it_) do { _Pragma("unroll") for (int i_ = 0; i_ < 2; ++i_) { const u32x4 o_ = *(const LAS u32x4*)(lds + OUTB + ((it_) & 1) * 16384 + (i_ * 512 + F.tid) * 16); \
              *(GAS u32x4*)((GAS bf16*)(F.ws + WS_GQK + (size_t)(2 * i_ + pqk) * GQK_STRIDE) + (row0 + GLA_TB(i_, it_) + ptk) * 512 + half * 256 + pc8) = o_; } } while (0)
          for (int i = F.tid; i < 128 * 32; i += NT) { const int tt = i >> 5, q = i & 31; ga[i] = bf2f(((const GAS bf16*)P0)[(row0 + tt) * N0 + C_GAF + q]); }
          GLA_DMA(0);
          asm volatile("s_waitcnt vmcnt(0) lgkmcnt(0)" ::: "memory"); __builtin_amdgcn_s_barrier();
          float Bc = 0.f;
#pragma unroll 1
          for (int it = 0; it < 16; ++it) {
              if (it + 1 < 16) GLA_DMA(it + 1);
              if (it > 0) GLA_FLUSH(it - 1);
              const LAS unsigned short* inq = (const LAS unsigned short*)(lds + INB + (it & 1) * 16384 + dir * 8192) + chl; LAS unsigned short* outq = (LAS unsigned short*)(lds + OUTB + (it & 1) * 16384 + dir * 8192) + chl;
#pragma unroll
              for (int j = 0; j < 8; ++j) { const int tk = dir ? 7 - j : j; const int tt = GLA_TB(dir, it) + tk;
                  const LAS f32x4* g = (const LAS f32x4*)(ga + tt * 32 + 16 * dir); float x = bias;
#pragma unroll
                  for (int q = 0; q < 4; ++q) { const f32x4 gq = g[q]; x += gq[0] * wv[4 * q] + gq[1] * wv[4 * q + 1] + gq[2] * wv[4 * q + 2] + gq[3] * wv[4 * q + 3]; }
                  const float xl = x * 1.4426950408889634f; const float l2 = fminf(xl, 0.f) - __builtin_amdgcn_logf(1.f + __builtin_amdgcn_exp2f(-fabsf(xl)));
                  Bc += l2 * (1.f / 16.f); const float e = __builtin_amdgcn_exp2f(Bc), ei = __builtin_amdgcn_exp2f(-Bc);
                  const float qv = bf2f(inq[tk * 256]), kv = bf2f(inq[2048 + tk * 256]);
                  outq[tk * 256] = f2bf(qv * qs * e); outq[2048 + tk * 256] = f2bf(kv * ei); }
              if (it > 0) asm volatile("s_waitcnt vmcnt(2)" ::: "memory"); else asm volatile("s_waitcnt vmcnt(0)" ::: "memory");
              asm volatile("s_waitcnt lgkmcnt(0)" ::: "memory"); __builtin_amdgcn_s_barrier();
          }
          GLA_FLUSH(15);
#undef GLA_TB
#undef GLA_DMA
#undef GLA_FLUSH
          GE[((size_t)(dir * 2 + b) * NCH + cid) * 512 + ch] = __builtin_amdgcn_exp2f(Bc);
          __syncthreads(); } }
}

__device__ __forceinline__ void moe_bases(const Frame& F, int* base  ) {
    int acc = 0;
#pragma unroll
    for (int e = 0; e < NEXP; ++e) { base[e] = acc; const int c = __builtin_amdgcn_readfirstlane((int)__hip_atomic_load(F.ctl + CW_MOE + 64 * e, RLX_AGENT)); acc += (c + 255) & ~255; }
    base[NEXP] = acc;
}
__device__ __forceinline__ void p_moe_gather(Frame& F) {
    const int gw = F.vcu * NWAVES + F.wave, NGW = F.G * NWAVES;
    int base[NEXP + 1]; moe_bases(F, base);
    const GAS int* topi = (const GAS int*)(F.ws + WS_TOPI); GAS int* pos = (GAS int*)(F.ws + WS_TOPI + 524288);
    const GAS unsigned char* H8 = (const GAS unsigned char*)(F.ws + WS_H8); GAS unsigned char* HG = (GAS unsigned char*)(F.ws + WS_HG);
    const int nmine = (MLAT - gw + NGW - 1) / NGW;
    for (int k0 = 0; k0 < nmine; k0 += 64) {
        int d0v = 0, d1v = 0;
        if (k0 + F.lane < nmine) { const int lr = gw + (k0 + F.lane) * NGW; const int e0 = topi[2 * lr], e1 = topi[2 * lr + 1]; int b0 = 0, b1 = 0;
#pragma unroll
            for (int j = 0; j < NEXP; ++j) { b0 = (e0 == j) ? base[j] : b0; b1 = (e1 == j) ? base[j] : b1; }
            d0v = b0 + pos[2 * lr]; d1v = b1 + pos[2 * lr + 1];
            pos[2 * lr] = d0v; pos[2 * lr + 1] = d1v; }
        const int kn = (nmine - k0 < 64) ? nmine - k0 : 64;
        for (int kb = 0; kb < kn; kb += 8) {
            u32x4 a0[8], a1[8];
#pragma unroll
            for (int q = 0; q < 8; ++q) if (kb + q < kn) { const int lr = gw + (k0 + kb + q) * NGW; const int b = lr / T, t = lr % T;
                const GAS u32x4* src = (const GAS u32x4*)(H8 + ((size_t)b * SA + t) * D); a0[q] = src[F.lane]; a1[q] = src[64 + F.lane]; }
#pragma unroll
            for (int q = 0; q < 8; ++q) if (kb + q < kn) { const int dA = __builtin_amdgcn_readlane(d0v, kb + q), dB = __builtin_amdgcn_readlane(d1v, kb + q);
                GAS u32x4* da = (GAS u32x4*)(HG + (size_t)dA * D); GAS u32x4* db = (GAS u32x4*)(HG + (size_t)dB * D);
                da[F.lane] = a0[q]; da[64 + F.lane] = a1[q]; db[F.lane] = a0[q]; db[64 + F.lane] = a1[q]; } } }
}
__device__ __forceinline__ void p_final(Frame& F, float* dst_override = nullptr) {
    const int gw = F.vcu * NWAVES + F.wave, NGW = F.G * NWAVES;
    const GAS float* topw = (const GAS float*)(F.ws + WS_TOPI + 262144); const GAS int* pos = (const GAS int*)(F.ws + WS_TOPI + 524288);
    const GAS bf16* Y = (const GAS bf16*)(F.ws + WS_Y); const GAS float* gfin = (const GAS float*)F.in[I_NFIN];
    const GAS float* mod1 = (const GAS float*)(F.ws + WS_MOD) + (size_t)3 * 12288;
    const GAS float* xin = (const GAS float*)F.out; GAS float* xout = (GAS float*)(dst_override ? dst_override : F.out);
    const int nmine = (MLAT - gw + NGW - 1) / NGW;
    const int c0 = 8 * F.lane;
    f32x4 gn[8];
#pragma unroll
    for (int j = 0; j < 4; ++j) { gn[2 * j] = *(const GAS f32x4*)(gfin + c0 + 512 * j); gn[2 * j + 1] = *(const GAS f32x4*)(gfin + c0 + 512 * j + 4); }
    f32x4 gg[8]; int curb = -1;
    for (int k0 = 0; k0 < nmine; k0 += 64) {
        int mp0 = 0, mp1 = 0; float mw0 = 0.f, mw1 = 0.f;
        { const int lrm = gw + (k0 + F.lane) * NGW; if (k0 + F.lane < nmine) { mp0 = pos[2 * lrm]; mp1 = pos[2 * lrm + 1]; mw0 = topw[2 * lrm]; mw1 = topw[2 * lrm + 1]; } }
        const int kn = (nmine - k0 < 64) ? nmine - k0 : 64;
        f32x4 x[8]; u32x4 ya[4], yc[4];
#define FIN_LOAD(X_, A_, C_, kk_) do { const GAS float* xr_ = xin + (size_t)(gw + (k0 + (kk_)) * NGW) * D + c0; \
          const GAS bf16* y0_ = Y + (size_t)__builtin_amdgcn_readlane(mp0, (kk_)) * D + c0; const GAS bf16* y1_ = Y + (size_t)__builtin_amdgcn_readlane(mp1, (kk_)) * D + c0; \
          _Pragma("unroll") for (int j = 0; j < 4; ++j) { X_[2 * j] = *(const GAS f32x4*)(xr_ + 512 * j); X_[2 * j + 1] = *(const GAS f32x4*)(xr_ + 512 * j + 4); A_[j] = *(const GAS u32x4*)(y0_ + 512 * j); C_[j] = *(const GAS u32x4*)(y1_ + 512 * j); } } while (0)
        FIN_LOAD(x, ya, yc, 0);
        for (int k = 0; k < kn; ++k) { const int lr = gw + (k0 + k) * NGW; const int b = lr / T;
            if (b != curb) { curb = b; const GAS float* gf = mod1 + (size_t)b * 12288 + 5 * 2048 + c0;
#pragma unroll
                for (int j = 0; j < 4; ++j) { gg[2 * j] = *(const GAS f32x4*)(gf + 512 * j); gg[2 * j + 1] = *(const GAS f32x4*)(gf + 512 * j + 4); } }
            const float w0 = __builtin_bit_cast(float, __builtin_amdgcn_readlane(__builtin_bit_cast(int, mw0), k)), w1 = __builtin_bit_cast(float, __builtin_amdgcn_readlane(__builtin_bit_cast(int, mw1), k));
            f32x4 xn[8]; u32x4 yan[4], ycn[4];
            { const int k1 = (k + 1 < kn) ? k + 1 : k; FIN_LOAD(xn, yan, ycn, k1); }
            f32x4 v[8]; float ss = 0.f;
#pragma unroll
            for (int j = 0; j < 4; ++j) { const u32x4 a = ya[j], c = yc[j];
                f32x4 y0v, y1v; y0v[0] = w0 * bflo(a.x) + w1 * bflo(c.x); y0v[1] = w0 * bfhi(a.x) + w1 * bfhi(c.x); y0v[2] = w0 * bflo(a.y) + w1 * bflo(c.y); y0v[3] = w0 * bfhi(a.y) + w1 * bfhi(c.y);
                y1v[0] = w0 * bflo(a.z) + w1 * bflo(c.z); y1v[1] = w0 * bfhi(a.z) + w1 * bfhi(c.z); y1v[2] = w0 * bflo(a.w) + w1 * bflo(c.w); y1v[3] = w0 * bfhi(a.w) + w1 * bfhi(c.w);
                v[2 * j] = x[2 * j] + gg[2 * j] * y0v; v[2 * j + 1] = x[2 * j + 1] + gg[2 * j + 1] * y1v; }
#pragma unroll
            for (int j = 0; j < 8; ++j) ss += (v[j][0] * v[j][0] + v[j][1] * v[j][1]) + (v[j][2] * v[j][2] + v[j][3] * v[j][3]);
            const float rs = rsqrtf(wave_sum(ss) * (1.f / D) + EPS);
            GAS float* xw = xout + (size_t)lr * D + c0;
#pragma unroll
            for (int j = 0; j < 4; ++j) { *(GAS f32x4*)(xw + 512 * j) = v[2 * j] * rs * gn[2 * j]; *(GAS f32x4*)(xw + 512 * j + 4) = v[2 * j + 1] * rs * gn[2 * j + 1]; }
#pragma unroll
            for (int j = 0; j < 8; ++j) x[j] = xn[j];
#pragma unroll
            for (int j = 0; j < 4; ++j) { ya[j] = yan[j]; yc[j] = ycn[j]; } }
#undef FIN_LOAD
    }
}

#define ONE_LAUNCH 1
#define DUPX 0
constexpr int NPHASE = 23;
#ifndef STOP_AFTER
#define STOP_AFTER 22
#endif
#ifndef PROBE_KIND
#define PROBE_KIND 0
#endif
#ifndef PROBE_OFF
#define PROBE_OFF 0
#endif
__global__ void __launch_bounds__(NT, 2) fwd_kernel(Args args) {
    extern __shared__ __attribute__((aligned(16))) unsigned char lds_raw[];
    Frame F;
    F.lds = (LAS unsigned char*)lds_raw; F.MISC = (volatile LAS unsigned*)(F.lds + MISC_OFF);
    F.tid = threadIdx.x; F.lane = F.tid & 63; F.wave = __builtin_amdgcn_readfirstlane(F.tid >> 6);
    F.G = gridDim.x; { const int bx = blockIdx.x; F.vcu = (F.G % 8 == 0) ? (bx % 8) * (F.G / 8) + bx / 8 : bx; }
    F.in = args.in; F.out = args.out; F.ws = args.ws; F.ctl = (unsigned*)(args.ws + WS_CTL);
    for (int u = F.tid; u < (LDS_BYTES - MISC_OFF) / 4; u += NT) ((LAS unsigned*)(F.lds + MISC_OFF))[u] = 0u;
    __syncthreads();
    const int lo = args.ph_lo, hi = args.ph_hi;
    XcdBarrier bar; bar.bar = F.ctl + CW_BAR; bar.x = 0; bar.st = nullptr;
    if (hi - lo > 1) bar = xcd_barrier_post(F.ctl + CW_BAR, F.MISC + 8);
#ifdef ONLY_PHASE
#define IN(k) ((k) == ONLY_PHASE && lo <= (k) && (k) < hi)
#else
#define IN(k) (lo <= (k) && (k) < hi)
#endif
#define SEAM(k) do { if (IN(k) && IN((k) + 1)) xcd_barrier_fill(bar, F, (k) >= 11); } while (0)
    const int cidx = (int)blockIdx.x;
#define PHASE_WS() unsigned char* ws = args.ws; asm volatile("" : "+s"(ws)); F.ws = ws; F.ctl = (unsigned*)(ws + WS_CTL); float* XC = (float*)(ws + WS_XC); bf16* H = (bf16*)(ws + WS_H); const float* mod0 = (const float*)(ws + WS_MOD); const float* mod1 = mod0 + 3 * 12288; (void)XC; (void)H; (void)mod0; (void)mod1
#define GLA_SRC(S) scan::Src S; S.q0 = (const bf16*)(ws + WS_GQK); S.k0 = (const bf16*)(ws + WS_GQK + GQK_STRIDE); S.q1 = (const bf16*)(ws + WS_GQK + 2 * GQK_STRIDE); S.k1 = (const bf16*)(ws + WS_GQK + 3 * GQK_STRIDE); \
        S.v = (const bf16*)(ws + WS_P0) + C_GV; S.ldq = 512; S.ldk = 512; S.ldv = N0; S.hsq = 128; S.hsv = 256; S.H = 4; S.ws = (bf16*)(ws + WS_GWS); S.egla = (const float*)(ws + WS_GE); S.rld = nullptr
#define RET_SRC(S) scan::Src S; { const bf16* P1 = (const bf16*)(ws + WS_P1); S.q0 = P1; S.k0 = P1 + 8 * P1PLANE; S.q1 = P1; S.k1 = P1 + 16 * P1PLANE; S.v = P1 + 24 * P1PLANE; S.ldq = S.ldk = S.ldv = 256; S.hsq = S.hsv = P1PLANE; S.H = 8; S.ws = (bf16*)(ws + WS_RWS); S.egla = nullptr; S.rld = F.in[I_RLD]; }

    if (IN(0)) { PHASE_WS(); p_prologue(F);
#if DUPX == 2 || DUPX == 7
        __syncthreads(); p_prologue(F);
#endif
#ifdef PROBE_PRO
        _Pragma("nounroll") for (int rep = 0; rep < 3; ++rep) { __syncthreads(); p_prologue(F); }
#endif
        } SEAM(0);
    if (IN(1)) { PHASE_WS(); p_norm<false>(F, 0, 0, false, F.in[I_X], F.in[I_CTX]);
#if DUPX == 2 || DUPX == 6
        p_norm<false>(F, 0, 0, false, F.in[I_X], F.in[I_CTX]);
#endif
        } SEAM(1);
    if (IN(2)) { PHASE_WS(); pg8::DenseOrder S; S.init(MALL / 256, N0 / 256, F.G, cidx, H, D * 2, ws + WS_W_IN0, D * 2, 0);
        EpiStoreBf16 E{(bf16*)(ws + WS_P0), N0}; pg8::gemm_phase(F.lds, D * 2, D * 2, D * 2, S, E); } SEAM(2);
    if (IN(3)) { PHASE_WS(); p_prep0(F);
#if DUPX == 2 || DUPX == 8
        __syncthreads(); p_prep0(F);
#endif
#ifdef PROBE_PREP0
        _Pragma("nounroll") for (int rep = 0; rep < 3; ++rep) { __syncthreads(); p_prep0(F); }
#endif
        } SEAM(3);
    if (IN(4)) { PHASE_WS();
        { pg8::DenseOrder S; S.init(MALL / 256, 1536 / 256, F.G, cidx, ws + WS_QLAT, 768 * 2, ws + WS_W_UQ, 768 * 2, 0);
          EpiQRope E{(bf16*)(ws + WS_Q), (const float*)(ws + WS_ROPE_M), (const float*)(ws + WS_ROPE_M) + ROPE_M_N, 0.07216878364870322f * 1.4426950408889634f};
#ifdef PROBE_P4Q
          _Pragma("nounroll") for (int rep = 0; rep < 3; ++rep) { pg8::gemm_phase(F.lds, 768 * 2, 768 * 2, 768 * 2, S, E); __syncthreads(); }
#endif
          pg8::gemm_phase(F.lds, 768 * 2, 768 * 2, 768 * 2, S, E); }
        { pg8::DenseOrder S; S.init(MALL / 256, 2048 / 256, F.G, (cidx + F.G - 12) % F.G, ws + WS_KVLAT, 512 * 2, ws + WS_W_UKV, 512 * 2, 0);
          EpiStoreBf16 E{(bf16*)(ws + WS_KV), 2048}; pg8::gemm_phase(F.lds, 512 * 2, 512 * 2, 512 * 2, S, E); }
#ifdef PROBE_P4A
        _Pragma("nounroll") for (int rep = 0; rep < 3; ++rep) { GLA_SRC(S); scan::phaseA<128>(S, F.lds, F.G, F.vcu); __syncthreads(); }
#endif
        { GLA_SRC(S); scan::phaseA<128>(S, F.lds, F.G, (F.vcu + F.G - 28) % F.G);
#if DUPX == 3
          scan::phaseA<128>(S, F.lds, F.G, F.vcu);
#endif
        }
    } SEAM(4);
#ifndef GLAB_PF
#define GLAB_PF 8
#endif
    if (IN(5)) { PHASE_WS(); GLA_SRC(S);
#ifdef PROBE_GB
        _Pragma("nounroll") for (int rep = 0; rep < 3; ++rep) { scan::phaseB<128, false, GLAB_PF>(S, F.G, F.vcu, (size_t)262 * 1024 * 1024 / 2); __syncthreads(); }
#endif
        scan::phaseB<128, false, GLAB_PF>(S, F.G, F.vcu);
        { const int nvb = (NB * 4 * 2 * 128 * 32 + NT - 1) / NT;
          if (nvb < F.G) p_ffn_copies(F, nvb); else p_ffn_copies(F, 0); } } SEAM(5);
    if (IN(6)) { PHASE_WS();
#ifndef NO_GLAC
        { GLA_SRC(S); scan::OutC O{(const bf16*)(ws + WS_P0) + C_GR, N0, F.in[I_GLAN], (bf16*)(ws + WS_MIX0), 256};
#ifdef PROBE_GC
          _Pragma("nounroll") for (int rep = 0; rep < 3; ++rep) { scan::phaseC<128, false>(S, O, NCH, F.lds, F.G, F.vcu); __syncthreads(); }
#endif
          scan::phaseC<128, false>(S, O, NCH, F.lds, F.G, F.vcu);
#if DUPX == 3
          scan::phaseC<128, false>(S, O, NCH, F.lds, F.G, F.vcu);
#endif
        }
#endif
        { const bf16* Q = (const bf16*)(ws + WS_Q); const bf16* KV = (const bf16*)(ws + WS_KV); const bf16* KR = (const bf16*)(ws + WS_KR); bf16* MIX = (bf16*)(ws + WS_MIX0);
#ifdef DUPATT
          for (int rep = 0; rep < 2; ++rep)
#endif
          for (int u = F.vcu; u < 16 * 65; u += F.G) { int bh, qb; if (u < 1024) { bh = u >> 6; qb = u & 63; } else { bh = u - 1024; qb = 64; }
              const int b = bh >> 3, h = bh & 7; const size_t qrow = (size_t)b * SA + (size_t)qb * 256; const size_t krow = (size_t)b * SA + (qb == 64 ? T : 0); const int nkeys = (qb == 64) ? CTX : SA;
              mla::attn_unit(Q + qrow * 1536 + h * 192, KV + krow * 2048 + h * 256, KV + krow * 2048 + h * 256 + 128, KR + krow * 64, MIX + qrow * 2048 + 1024 + h * 128, nkeys, F.lds); }
          __syncthreads(); }
    } SEAM(6);
    if (IN(7)) { PHASE_WS(); pg8::DenseOrder S; S.init(MALL / 256, D / 256, F.G, cidx, ws + WS_MIX0, D * 2, ws + WS_W_OUT0, D * 2, 0);
        EpiResid E{F.in[I_X], F.in[I_CTX], F.out, XC, mod0 + 2 * 2048}; pg8::gemm_phase(F.lds, D * 2, D * 2, D * 2, S, E); } SEAM(7);
    if (IN(8)) { PHASE_WS(); p_norm<false>(F, 0, 1, false, F.out, XC);
#if DUPX == 2 || DUPX == 6
        p_norm<false>(F, 0, 1, false, F.out, XC);
#endif
        } SEAM(8);
    if (IN(9)) { PHASE_WS(); pg8::DenseOrder S; S.init(MALL / 256, 2 * DFF / 256, F.G, cidx, H, D * 2, ws + WS_W_GU, D * 2, 0);
        EpiSwiGLUto8 E{ws + WS_HID, DFF}; pg8::gemm_phase(F.lds, D * 2, D * 2, D * 2, S, E); } SEAM(9);
    if (IN(10)) { PHASE_WS(); pg8::DenseOrder S; S.init(MALL / 256, D / 256, F.G, cidx, ws + WS_HID, DFF, ws + WS_W_DN, DFF, 0);
        EpiResid E{F.out, XC, F.out, XC, mod0 + 5 * 2048, 1.f / (W8_SCALE * H8_SCALE)}; pg8::gemm_phase<EpiResid, pg8::DenseOrder, true>(F.lds, DFF, DFF, DFF, S, E); } SEAM(10);
    if (IN(11)) { PHASE_WS(); p_norm<false>(F, 1, 0, false, F.out, XC);
#if DUPX == 2 || DUPX == 6
        p_norm<false>(F, 1, 0, false, F.out, XC);
#endif
        } SEAM(11);
    if (IN(12)) { PHASE_WS(); pg8::DenseOrder S; S.init(MALL / 256, N1 / 256, F.G, cidx, H, D * 2, ws + WS_W_IN1, D * 2, 0);
        EpiIn1 E{(bf16*)(ws + WS_P1), (const float*)(ws + WS_ROPE_R), (const float*)(ws + WS_ROPE_R) + ROPE_R_N, F.in[I_RLD]}; pg8::gemm_phase(F.lds, D * 2, D * 2, D * 2, S, E); } SEAM(12);
    if (IN(13)) { PHASE_WS(); RET_SRC(RS);
#ifdef ABPROBE
        for (int rep = 0; rep < 3; ++rep) { scan::phaseAB<256, ABPROBE>(RS, F.lds, F.G, F.vcu); __syncthreads(); }
#endif
        scan::phaseAB<256>(RS, F.lds, F.G, F.vcu); }
    if (IN(13) && IN(15)) xcd_barrier_fill(bar, F, true);
    if (IN(15)) { PHASE_WS(); RET_SRC(RS); scan::OutC O{(const bf16*)(ws + WS_P1) + 32 * P1PLANE, 256, F.in[I_RETN], (bf16*)(ws + WS_MIX1), P1PLANE};
#ifdef PROBE_C
        _Pragma("nounroll") for (int rep = 0; rep < 3; ++rep) { scan::phaseC<256, true, PROBE_C & 15>(RS, O, 128, F.lds, F.G, F.vcu); __syncthreads(); }
#endif
        scan::phaseC<256, true>(RS, O, 128, F.lds, F.G, F.vcu);
#if DUPX == 3 || DUPX == 5
        scan::phaseC<256, true>(RS, O, 128, F.lds, F.G, F.vcu);
#endif
        } SEAM(15);
    if (IN(16)) { PHASE_WS(); pg8::DenseOrder S; S.init(MLAT / 256, D / 256, F.G, cidx, ws + WS_MIX1, D * 2, ws + WS_W_OUT1, D * 2, 1);
        EpiResid E{F.out, XC, F.out, XC, mod1 + 2 * 2048}; pg8::gemm_phase(F.lds, D * 2, D * 2, D * 2, S, E); } SEAM(16);
    if (IN(17)) { PHASE_WS(); p_norm<true, true>(F, 1, 1, true, F.out, XC); } SEAM(17);
    if (IN(18)) { PHASE_WS(); p_moe_gather(F); p_conv_drain(F, bar.x); } SEAM(18);
    if (IN(19)) { PHASE_WS(); pg8::GroupedOrder S; int base[NEXP + 1]; moe_bases(F, base);
#pragma unroll
        for (int e = 0; e <= NEXP; ++e) S.ts[e] = base[e] >> 8;
        S.nM = S.ts[NEXP]; S.nN = 2 * DFF / 256; S.nwg = S.nM * S.nN; S.G = F.G; S.c = cidx; S.A = (const char*)(ws + WS_HG); S.Bt = (const char*)(ws + WS_WMOE); S.tstepA = (size_t)256 * D; S.tstepB = (size_t)256 * D; S.estride = (size_t)2 * DFF * D;
        EpiSwiGLU8 E{ws + WS_HIDM, DFF}; pg8::gemm_phase<EpiSwiGLU8, pg8::GroupedOrder, true>(F.lds, D, D, D, S, E); } SEAM(19);
    if (IN(21)) { PHASE_WS(); pg8::GroupedOrder S; int base[NEXP + 1]; moe_bases(F, base);
#pragma unroll
        for (int e = 0; e <= NEXP; ++e) S.ts[e] = base[e] >> 8;
        S.nM = S.ts[NEXP]; S.nN = D / 256; S.nwg = S.nM * S.nN; S.G = F.G; S.c = cidx; S.A = (const char*)(ws + WS_HIDM); S.Bt = (const char*)(ws + WS_WMOE_DN); S.tstepA = (size_t)256 * DFF; S.tstepB = (size_t)256 * DFF; S.estride = (size_t)D * DFF;
        EpiStoreBf16 E{(bf16*)(ws + WS_Y), D, 1.f / (W8_SCALE * H8_SCALE)}; pg8::gemm_phase<EpiStoreBf16, pg8::GroupedOrder, true>(F.lds, DFF, DFF, DFF, S, E); } SEAM(21);
    if (IN(22)) { PHASE_WS();
#ifdef PROBE_FIN
        _Pragma("nounroll") for (int rep = 0; rep < 3; ++rep) { p_final(F, (float*)(ws + WS_RWS)); __syncthreads(); }
#endif
        p_final(F); }
    if (PROBE_KIND && lo == 100) { PHASE_WS(); const bf16* src = (const bf16*)(ws + (size_t)PROBE_OFF); for (size_t i = (size_t)blockIdx.x * NT + F.tid; i < (size_t)MLAT * D; i += (size_t)F.G * NT) F.out[i] = bf2f(src[i]); }
#undef IN
#undef SEAM
}

extern "C" void kernel_launch(void* const* d_in, const int* in_sizes, int n_in, void* d_out, int out_size, void* d_ws, size_t ws_size, hipStream_t stream) {
    static int grid = 0;
    if (grid == 0) {
        if (n_in != 29 || out_size != MLAT * D || ws_size < WS_END) { fprintf(stderr, "kernel_launch: unexpected shapes (n_in %d out %d ws %zu)\n", n_in, out_size, ws_size); grid = -1; return; }
        int dev = 0, cus = 0;
        if (hipGetDevice(&dev) != hipSuccess || hipDeviceGetAttribute(&cus, hipDeviceAttributeMultiprocessorCount, dev) != hipSuccess) { grid = -1; return; }
        if (hipFuncSetAttribute((const void*)fwd_kernel, hipFuncAttributeMaxDynamicSharedMemorySize, LDS_BYTES) != hipSuccess) { fprintf(stderr, "kernel_launch: hipFuncSetAttribute failed\n"); grid = -1; return; }
        int per_cu = 0; (void)hipOccupancyMaxActiveBlocksPerMultiprocessor(&per_cu, (const void*)fwd_kernel, NT, LDS_BYTES); (void)hipGetLastError();
        grid = cus;
    }
    if (grid < 0) return;
    (void)hipMemsetAsync((char*)d_ws + WS_CTL, 0, CTL_ZERO_BYTES, stream);
#ifdef DEBUG_NANFILL
    (void)hipMemsetAsync((char*)d_ws + CTL_ZERO_BYTES, 0xFF, WS_END - CTL_ZERO_BYTES, stream);
#endif
    Args a{};
    for (int i = 0; i < 29; ++i) a.in[i] = (const float*)d_in[i];
    a.out = (float*)d_out; a.ws = (unsigned char*)d_ws;
#ifndef ONE_LAUNCH
    for (int p = 0; p < NPHASE && p <= STOP_AFTER; ++p) { a.ph_lo = p; a.ph_hi = p + 1; hipLaunchKernelGGL(fwd_kernel, dim3(grid), dim3(NT), LDS_BYTES, stream, a); }
    if (PROBE_KIND) { a.ph_lo = 100; a.ph_hi = 101; hipLaunchKernelGGL(fwd_kernel, dim3(grid), dim3(NT), LDS_BYTES, stream, a); }
#else
    a.ph_lo = 0; a.ph_hi = NPHASE; hipLaunchKernelGGL(fwd_kernel, dim3(grid), dim3(NT), LDS_BYTES, stream, a);
#endif
}
```

```cpp
#include <hip/hip_runtime.h>
#include <cstdio>
#include <cstdint>

#define GAS __attribute__((address_space(1)))
#define LAS __attribute__((address_space(3)))
typedef unsigned short bf16;
typedef short bf16x8 __attribute__((ext_vector_type(8)));
typedef short s16x4 __attribute__((ext_vector_type(4)));
typedef float f32x2 __attribute__((ext_vector_type(2)));
typedef float f32x4 __attribute__((ext_vector_type(4)));
typedef float f32x16 __attribute__((ext_vector_type(16)));
typedef unsigned u32x2 __attribute__((ext_vector_type(2)));
typedef unsigned u32x4 __attribute__((ext_vector_type(4)));

constexpr int D = 2048, NB = 2, T = 16384, CTX = 256, SA = T + CTX  , MALL = NB * SA  , MLAT = NB * T;
constexpr int DFF = 5632, NEXP = 8;
constexpr float EPS = 1e-6f;
constexpr int N0 = 4608, C_GQ = 0, C_GK = 512, C_GV = 1024, C_GR = 2048, C_MQ = 3072, C_MKV = 3840, C_MKR = 4352, C_GAF = 4416, C_GAB = 4432;
constexpr int N1 = 8192;
constexpr int NCH = SA / 128;
constexpr int MOE_ROWS = 2 * MLAT + NEXP * 256;

constexpr size_t MiB = 1u << 20;
constexpr size_t WS_CTL = 0, CTL_ZERO_BYTES = 1 * MiB;
constexpr size_t WS_MOD = 1 * MiB;
constexpr size_t WS_XC = 2 * MiB;
constexpr size_t WS_TOPI = 6 * MiB;
constexpr size_t WS_ROPE_M = 8 * MiB;
constexpr size_t WS_ROPE_R = 12 * MiB;
constexpr int ROPE_M_N = 320 * 16, ROPE_R_N = 320 * 64;
constexpr size_t WS_W_IN0 = 28 * MiB, WS_W_UQ = 46 * MiB, WS_W_UKV = 49 * MiB, WS_W_OUT0 = 51 * MiB, WS_W_GU = 59 * MiB, WS_W_DN = 103 * MiB, WS_W_IN1 = 125 * MiB, WS_W_OUT1 = 157 * MiB;
constexpr size_t WS_H = 168 * MiB;
constexpr size_t WS_BIG = 298 * MiB;
constexpr size_t WS_P0 = WS_BIG;
constexpr size_t WS_QLAT = 591 * MiB, WS_KVLAT = 640 * MiB, WS_Q = 673 * MiB, WS_KV = 771 * MiB, WS_KR = 901 * MiB;
constexpr size_t WS_GQK = 906 * MiB;
constexpr size_t GQK_STRIDE = (size_t)MALL * 512 * 2;
constexpr size_t WS_GE = 1036 * MiB;
constexpr size_t WS_GWS = 1038 * MiB;
constexpr size_t WS_MIX0 = 1168 * MiB;
constexpr size_t WS_HID = WS_BIG;
constexpr size_t WS_P1 = WS_BIG;
constexpr size_t WS_RWS = 1078 * MiB;
constexpr size_t WS_MIX1 = WS_H;
constexpr size_t WS_H8 = WS_H;
constexpr size_t WS_HG = WS_BIG;
constexpr size_t WS_HIDM = 430 * MiB;
constexpr size_t WS_Y = 793 * MiB;
constexpr size_t WS_WMOE = 1598 * MiB;
constexpr size_t WS_WMOE_DN = 28 * MiB;
constexpr size_t WS_END = 1774 * MiB;

constexpr int CW_TMO = 0, CW_CODE = 1;
constexpr int CW_BAR = 4096;
constexpr int CW_MOE = 8192;
constexpr int CW_SUB = 16384;
constexpr int CW_CQ = 12288;
constexpr int CQ_GU_ROUNDS = NEXP * 2 * 5632 / 64;
constexpr int CQ_DN_ROUNDS = NEXP * 5632 / 64;

constexpr int SCR_BYTES = 143360;
constexpr int MISC_OFF = SCR_BYTES;
constexpr int LDS_BYTES = 147456;
constexpr int NWAVES = 8, NT = 512;

#define RLX_AGENT __ATOMIC_RELAXED, __HIP_MEMORY_SCOPE_AGENT
#define LDS_WAIT() asm volatile("s_waitcnt lgkmcnt(0)" ::: "memory")
#define VM_WAIT() asm volatile("s_waitcnt vmcnt(0)" ::: "memory")
#define SBAR() __builtin_amdgcn_sched_barrier(0)

__device__ __forceinline__ unsigned cvtpk(float lo, float hi) { unsigned r; asm volatile("v_cvt_pk_bf16_f32 %0, %1, %2" : "=v"(r) : "v"(lo), "v"(hi)); return r; }
__device__ __forceinline__ float bflo(unsigned w) { return __uint_as_float(w << 16); }
__device__ __forceinline__ float bfhi(unsigned w) { return __uint_as_float(w & 0xffff0000u); }
__device__ __forceinline__ float bf2f(bf16 b) { return __uint_as_float(((unsigned)b) << 16); }
__device__ __forceinline__ bf16 f2bf(float f) { return (bf16)(cvtpk(f, f) & 0xffffu); }
__device__ __forceinline__ bf16 f2bf_sw(float f) { const unsigned u = __float_as_uint(f); return (bf16)((u + 0x7fffu + ((u >> 16) & 1u)) >> 16); }
__device__ __forceinline__ float silu_f(float x) { return x * __builtin_amdgcn_rcpf(1.f + __builtin_amdgcn_exp2f(x * -1.4426950408889634f)); }
__device__ __forceinline__ float wave_sum(float v) {
#pragma unroll
    for (int o = 1; o < 64; o <<= 1) v += __shfl_xor(v, o);
    return v;
}
__device__ __forceinline__ int crow(int r, int hi) { return (r & 3) + 8 * (r >> 2) + 4 * hi; }

namespace pg8 {
constexpr int BM = 256, BK = 64, HALF = 128, HTB = HALF * BK * 2, STAGE_BYTES = 8 * HTB, NXCD = 8, WGM = 4;
__host__ __device__ __forceinline__ int lds_byte(int r, int c) { const int st = (r >> 4) * 2 + (c >> 5), rr = r & 15, cc = c & 31, ob = rr * 64 + cc * 2; return st * 1024 + (ob ^ (((ob >> 9) & 1) << 5)); }
__host__ __device__ __forceinline__ void stage_rc(int b, int& R, int& C) { const int st = b / 1024, sb = b % 1024, swz = sb ^ (((sb >> 9) & 1) << 5); R = (st >> 1) * 16 + swz / 64; C = (st & 1) * 32 + (swz % 64) / 2; }
__host__ __device__ __forceinline__ int perm32(int rho) { const int n = rho >> 4, i = rho & 15; return 8 * (i >> 2) + 4 * n + (i & 3); }

struct Unit { int pm, pn; };
__device__ __forceinline__ const char* sptr(const char* p) { const unsigned long long v = (unsigned long long)p; const unsigned lo = __builtin_amdgcn_readfirstlane((unsigned)v), hi = __builtin_amdgcn_readfirstlane((unsigned)(v >> 32)); return (const char*)(((unsigned long long)hi << 32) | lo); }

struct DenseOrder {
    int nM, nN, nwg, G, c, skipctx; const char* A; const char* Bt; size_t tstepA, tstepB;
    __device__ void init(int nM_, int nN_, int G_, int c_, const void* A_, size_t lda_bytes, const void* Bt_, size_t ldb_bytes, int skipctx_) {
        nM = nM_; nN = nN_; nwg = nM * nN; G = G_; c = c_; A = (const char*)A_; Bt = (const char*)Bt_; tstepA = 256 * lda_bytes; tstepB = 256 * ldb_bytes; skipctx = skipctx_; }
    __device__ bool next(int i, Unit& u) const {
        const long L = (long)i * G + c; if (L >= nwg) return false;
        int wgid = (int)L; { const int q = nwg / NXCD, r = nwg % NXCD, xcd = wgid % NXCD, off = wgid / NXCD; wgid = (xcd < r ? xcd * (q + 1) : r * (q + 1) + (xcd - r) * q) + off; }
        const int nig = WGM * nN, gid = wgid / nig, fm = gid * WGM, gsz = (nM - fm) < WGM ? (nM - fm) : WGM;
        int pm = fm + ((wgid % nig) % gsz); u.pn = (wgid % nig) / gsz;
        if (skipctx && pm >= 64) pm += 1;
        u.pm = pm; return true;
    }
    __device__ __forceinline__ const char* a_ptr(const Unit& u) const { return A + (size_t)u.pm * tstepA; }
    __device__ __forceinline__ const char* b_ptr(const Unit& u) const { return Bt + (size_t)u.pn * tstepB; }
};
struct CtxOrder {
    int nN, G, c; const char* A; const char* Bt; size_t tstepA, tstepB;
    __device__ void init(int nN_, int G_, int c_, const void* A_, size_t lda_bytes, const void* Bt_, size_t ldb_bytes) { nN = nN_; G = G_; c = c_; A = (const char*)A_; Bt = (const char*)Bt_; tstepA = 256 * lda_bytes; tstepB = 256 * ldb_bytes; }
    __device__ bool next(int i, Unit& u) const { const long L = (long)i * G + c; if (L >= 2 * nN) return false; u.pm = (L >= nN) ? 129 : 64; u.pn = (int)(L % nN); return true; }
    __device__ __forceinline__ const char* a_ptr(const Unit& u) const { return A + (size_t)u.pm * tstepA; }
    __device__ __forceinline__ const char* b_ptr(const Unit& u) const { return Bt + (size_t)u.pn * tstepB; }
};
struct GroupedOrder {
    int nM, nN, nwg, G, c; const char* A; const char* Bt; size_t tstepA, tstepB, estride; int ts[NEXP + 1];
    __device__ bool next(int i, Unit& u) const {
        const long L = (long)i * G + c; if (L >= nwg) return false;
        int wgid = (int)L; { const int q = nwg / NXCD, r = nwg % NXCD, xcd = wgid % NXCD, off = wgid / NXCD; wgid = (xcd < r ? xcd * (q + 1) : r * (q + 1) + (xcd - r) * q) + off; }
        const int nig = WGM * nN, gid = wgid / nig, fm = gid * WGM, gsz = (nM - fm) < WGM ? (nM - fm) : WGM;
        u.pm = fm + ((wgid % nig) % gsz); u.pn = (wgid % nig) / gsz; return true;
    }
    __device__ __forceinline__ const char* a_ptr(const Unit& u) const { return A + (size_t)u.pm * tstepA; }
    __device__ __forceinline__ const char* b_ptr(const Unit& u) const {
        int e = 0;
#pragma unroll
        for (int j = 1; j < NEXP; ++j) e += (u.pm >= ts[j]) ? 1 : 0;
        return Bt + (size_t)e * estride + (size_t)u.pn * tstepB; }
};

typedef int v8i __attribute__((ext_vector_type(8)));
typedef int v4i __attribute__((ext_vector_type(4)));
template <class Epi, class Sched, bool FP8 = false, bool ALIGN_EPI = true, bool SP2 = true>
__device__ __forceinline__ void gemm_phase(LAS unsigned char* lds, const int Kb, const int ldab, const int ldbb, const Sched& S, const Epi& E) {
    const int tid = threadIdx.x, wid = __builtin_amdgcn_readfirstlane(tid >> 6), lane = tid & 63, wr = wid >> 2, wc = wid & 3, fr = lane & 15, fq = lane >> 4;
    const int nt = Kb / 128;
    unsigned voffA[2], voffB[2];
#pragma unroll
    for (int i = 0; i < 2; ++i) { int R, C; stage_rc(tid * 16 + i * 8192, R, C); const int Rb = Epi::PERM ? ((R & ~31) + perm32(R & 31)) : R;
        voffA[i] = (unsigned)(R * ldab + C * 2); voffB[i] = (unsigned)(Rb * ldbb + C * 2); }
    const size_t kstep = (size_t)(BK * 2);
    const size_t hstepA = (size_t)HALF * ldab, hstepB = (size_t)HALF * ldbb;
    const unsigned ldsw = (unsigned)wid * 1024u;
    const int aoff = lds_byte(wr * 64 + fr, fq * 8), boff = lds_byte(wc * 32 + fr, fq * 8);
#define PG8_SA(b, h) (((b) * 2 + (h)) * HTB)
#define PG8_SB(b, h) ((4 + (b) * 2 + (h)) * HTB)
#define PG8_STAGE(bufoff, gbase, voff) do { _Pragma("unroll") for (int _i = 0; _i < 2; ++_i) \
        __builtin_amdgcn_global_load_lds((const unsigned*)((const char*)(gbase) + (voff)[_i]), (LAS unsigned*)(lds + (bufoff) + ldsw + _i * 8192), 16, 0, 0); } while (0)
#define PG8_LDA(dst, b, h) do { _Pragma("unroll") for (int m = 0; m < 4; ++m) _Pragma("unroll") for (int k = 0; k < 2; ++k) dst[m][k] = *(const LAS bf16x8*)(lds + PG8_SA(b, h) + aoff + m * 2048 + k * 1024); } while (0)
#define PG8_LDB(dst, b, h) do { _Pragma("unroll") for (int n = 0; n < 2; ++n) _Pragma("unroll") for (int k = 0; k < 2; ++k) dst[n][k] = *(const LAS bf16x8*)(lds + PG8_SB(b, h) + boff + n * 2048 + k * 1024); } while (0)
#define PG8_CAT(x) __builtin_shufflevector(__builtin_bit_cast(v4i, x[0]), __builtin_bit_cast(v4i, x[1]), 0, 1, 2, 3, 4, 5, 6, 7)
#define PG8_MMA(ai, bj, At, Bt) do { __builtin_amdgcn_s_setprio(1); if constexpr (FP8) { _Pragma("unroll") for (int m = 0; m < 4; ++m) _Pragma("unroll") for (int n = 0; n < 2; ++n) \
        { const v8i a8_ = PG8_CAT(Bt[n]), b8_ = PG8_CAT(At[m]); asm volatile("v_mfma_scale_f32_16x16x128_f8f6f4 %0, %1, %2, %0, %3, %3 op_sel_hi:[0,0,0]" : "+v"(acc[ai][bj][m][n]) : "v"(a8_), "v"(b8_), "v"(one8)); } } else { \
        _Pragma("unroll") for (int m = 0; m < 4; ++m) _Pragma("unroll") for (int n = 0; n < 2; ++n) _Pragma("unroll") for (int k = 0; k < 2; ++k) \
        acc[ai][bj][m][n] = __builtin_amdgcn_mfma_f32_16x16x32_bf16(Bt[n][k], At[m][k], acc[ai][bj][m][n], 0, 0, 0); } __builtin_amdgcn_s_setprio(0); } while (0)
#define PG8_WAIT_V(n) asm volatile("s_waitcnt vmcnt(" #n ")" ::: "memory")
#define PG8_WAIT_L(n) asm volatile("s_waitcnt lgkmcnt(" #n ")" ::: "memory")
#define PG8_BAR __builtin_amdgcn_s_barrier()
#define PG8_SCHED __builtin_amdgcn_sched_barrier(0)
    Unit cur, nxt; int ui = 0;
    if (!S.next(0, cur)) return;
    f32x4 acc[2][2][4][2];
#pragma unroll
    for (int a = 0; a < 2; ++a)
#pragma unroll
        for (int b = 0; b < 2; ++b)
#pragma unroll
            for (int m = 0; m < 4; ++m)
#pragma unroll
                for (int n = 0; n < 2; ++n) acc[a][b][m][n] = (f32x4){0.f, 0.f, 0.f, 0.f};
    bf16x8 At[4][2], B0[2][2], B1[2][2];
    int one8 = 0x7f7f7f7f; asm volatile("" : "+v"(one8));
    const char* cA = sptr(S.a_ptr(cur)); const char* cB = sptr(S.b_ptr(cur));
    if constexpr (SP2) {
        PG8_STAGE(PG8_SB(0, 0), cB, voffB); PG8_STAGE(PG8_SB(0, 1), cB + hstepB, voffB); PG8_STAGE(PG8_SA(0, 0), cA, voffA); PG8_STAGE(PG8_SA(0, 1), cA + hstepA, voffA);
        if (wr == 1) PG8_BAR;
        PG8_WAIT_V(2); PG8_BAR;
        PG8_STAGE(PG8_SB(1, 0), cB + kstep, voffB); PG8_STAGE(PG8_SA(1, 0), cA + kstep, voffA); PG8_STAGE(PG8_SB(1, 1), cB + hstepB + kstep, voffB);
        PG8_WAIT_V(6); PG8_BAR;
    } else {
        PG8_STAGE(PG8_SB(0, 0), cB, voffB); PG8_STAGE(PG8_SA(0, 0), cA, voffA); PG8_STAGE(PG8_SB(0, 1), cB + hstepB, voffB); PG8_STAGE(PG8_SA(0, 1), cA + hstepA, voffA);
        if (wr == 1) PG8_BAR;
        PG8_WAIT_V(4); PG8_BAR;
        PG8_STAGE(PG8_SB(1, 0), cB + kstep, voffB); PG8_STAGE(PG8_SA(1, 0), cA + kstep, voffA); PG8_STAGE(PG8_SB(1, 1), cB + hstepB + kstep, voffB);
        PG8_WAIT_V(6); PG8_BAR;
    }
    for (;;) {
        const bool has_next = S.next(ui + 1, nxt);
        const char* nA = sptr(has_next ? S.a_ptr(nxt) : cA); const char* nB = sptr(has_next ? S.b_ptr(nxt) : cB);
        for (int t = 0; t < nt; t += 2) {
            const bool last = (t == nt - 2);
            const char* a1 = cA + (size_t)(t + 1) * kstep;
            const char* a2 = sptr(last ? nA : cA + (size_t)(t + 2) * kstep); const char* b2 = sptr(last ? nB : cB + (size_t)(t + 2) * kstep);
            const char* a3 = a2 + kstep; const char* b3 = b2 + kstep;
            if constexpr (SP2) {
            PG8_LDB(B0, 0, 0); PG8_LDB(B1, 0, 1); PG8_SCHED; PG8_LDA(At, 0, 0); PG8_STAGE(PG8_SA(1, 1), a1 + hstepA, voffA);
            PG8_WAIT_V(8); PG8_WAIT_L(0); PG8_BAR; PG8_MMA(0, 0, At, B0); PG8_MMA(0, 1, At, B1); PG8_BAR; PG8_SCHED;
            PG8_LDA(At, 0, 1); PG8_STAGE(PG8_SB(0, 0), b2, voffB); PG8_STAGE(PG8_SB(0, 1), b2 + hstepB, voffB); PG8_STAGE(PG8_SA(0, 0), a2, voffA);
            PG8_WAIT_V(8); PG8_WAIT_L(0); PG8_BAR; PG8_MMA(1, 0, At, B0); PG8_MMA(1, 1, At, B1); PG8_BAR; PG8_SCHED;
            PG8_LDB(B0, 1, 0); PG8_LDB(B1, 1, 1); PG8_SCHED; PG8_LDA(At, 1, 0); PG8_STAGE(PG8_SA(0, 1), a2 + hstepA, voffA);
            PG8_WAIT_V(8); PG8_WAIT_L(0); PG8_BAR; PG8_MMA(0, 0, At, B0); PG8_MMA(0, 1, At, B1); PG8_BAR; PG8_SCHED;
            PG8_LDA(At, 1, 1); PG8_STAGE(PG8_SB(1, 0), b3, voffB); PG8_STAGE(PG8_SB(1, 1), b3 + hstepB, voffB); PG8_STAGE(PG8_SA(1, 0), a3, voffA);
            PG8_WAIT_V(8); PG8_WAIT_L(0); PG8_BAR; PG8_MMA(1, 0, At, B0); PG8_MMA(1, 1, At, B1); PG8_BAR; PG8_SCHED;
            } else {
            PG8_LDB(B0, 0, 0); PG8_SCHED; PG8_LDA(At, 0, 0); PG8_STAGE(PG8_SA(1, 1), a1 + hstepA, voffA);
            PG8_WAIT_L(8); PG8_BAR; PG8_WAIT_L(0); PG8_MMA(0, 0, At, B0); PG8_BAR; PG8_SCHED;
            PG8_LDB(B1, 0, 1); PG8_STAGE(PG8_SB(0, 0), b2, voffB);
            PG8_BAR; PG8_WAIT_L(0); PG8_MMA(0, 1, At, B1); PG8_BAR;
            PG8_LDA(At, 0, 1); PG8_STAGE(PG8_SA(0, 0), a2, voffA);
            PG8_BAR; PG8_WAIT_L(0); PG8_MMA(1, 0, At, B0); PG8_BAR; PG8_SCHED;
            PG8_STAGE(PG8_SB(0, 1), b2 + hstepB, voffB);
            PG8_WAIT_V(6); PG8_BAR; PG8_MMA(1, 1, At, B1); PG8_BAR;
            PG8_LDB(B0, 1, 0); PG8_SCHED; PG8_LDA(At, 1, 0); PG8_STAGE(PG8_SA(0, 1), a2 + hstepA, voffA);
            PG8_WAIT_L(8); PG8_BAR; PG8_WAIT_L(0); PG8_MMA(0, 0, At, B0); PG8_BAR; PG8_SCHED;
            PG8_LDB(B1, 1, 1); PG8_STAGE(PG8_SB(1, 0), b3, voffB);
            PG8_BAR; PG8_WAIT_L(0); PG8_MMA(0, 1, At, B1); PG8_BAR;
            PG8_LDA(At, 1, 1); PG8_STAGE(PG8_SA(1, 0), a3, voffA);
            PG8_BAR; PG8_WAIT_L(0); PG8_MMA(1, 0, At, B0); PG8_BAR; PG8_SCHED;
            PG8_STAGE(PG8_SB(1, 1), b3 + hstepB, voffB);
            PG8_WAIT_V(6); PG8_BAR; PG8_MMA(1, 1, At, B1); PG8_BAR;
            }
        }
        if constexpr (ALIGN_EPI) { if (wr == 0) PG8_BAR; }
        if constexpr (FP8) asm volatile("s_nop 15\n\ts_nop 15" ::: "memory");
        E(acc, cur, wr, wc, fr, fq);
        if (!has_next) break;
#pragma unroll
        for (int a = 0; a < 2; ++a)
#pragma unroll
            for (int b = 0; b < 2; ++b)
#pragma unroll
                for (int m = 0; m < 4; ++m)
#pragma unroll
                    for (int n = 0; n < 2; ++n) acc[a][b][m][n] = (f32x4){0.f, 0.f, 0.f, 0.f};
        cur = nxt; cA = nA; cB = nB; ++ui;
        if constexpr (ALIGN_EPI) { if (wr == 1) PG8_BAR; }
    }
    PG8_WAIT_V(0);
    if constexpr (!ALIGN_EPI) { if (wr == 0) PG8_BAR; }
    PG8_BAR;
#undef PG8_SA
#undef PG8_SB
#undef PG8_STAGE
#undef PG8_LDA
#undef PG8_LDB
#undef PG8_MMA
#undef PG8_CAT
#undef PG8_WAIT_V
#undef PG8_WAIT_L
#undef PG8_BAR
#undef PG8_SCHED
}
}

typedef pg8::Unit GUnit;
__device__ __forceinline__ u32x4 pack8(const f32x4& v0, const f32x4& v1) { u32x4 w; w.x = cvtpk(v0[0], v0[1]); w.y = cvtpk(v0[2], v0[3]); w.z = cvtpk(v1[0], v1[1]); w.w = cvtpk(v1[2], v1[3]); return w; }

struct EpiStoreBf16 {
    static constexpr bool PERM = true;
    bf16* O; int ldc; float sc = 1.f;
    __device__ __forceinline__ void operator()(const f32x4 (&acc)[2][2][4][2], const GUnit& u, int wr, int wc, int fr, int fq) const {
        asm volatile("" : "+v"(fr), "+v"(fq));
        const int row0 = u.pm * 256 + wr * 64 + fr, col0 = u.pn * 256 + wc * 32 + 8 * fq;
#pragma unroll
        for (int ai = 0; ai < 2; ++ai)
#pragma unroll
            for (int m = 0; m < 4; ++m) { bf16* rowp = O + (size_t)(row0 + ai * 128 + m * 16) * ldc + col0;
#pragma unroll
                for (int bj = 0; bj < 2; ++bj) *(GAS u32x4*)(rowp + bj * 128) = pack8(acc[ai][bj][m][0] * sc, acc[ai][bj][m][1] * sc); }
    }
};
struct EpiQRope {
    static constexpr bool PERM = true;
    bf16* Q; const float* cs; const float* sn; float qscale;
    __device__ __forceinline__ void operator()(const f32x4 (&acc)[2][2][4][2], const GUnit& u, int wr, int wc, int fr, int fq) const {
        asm volatile("" : "+v"(fr), "+v"(fq));
        const int w = u.pm % 65; const bool latent = w < 64;
        const int rit0 = wr * 64 + fr;
#pragma unroll
        for (int ai = 0; ai < 2; ++ai)
#pragma unroll
            for (int m = 0; m < 4; ++m) { const int rit = rit0 + ai * 128 + m * 16; const int t = w * 256 + rit;
                bf16* rowp = Q + (size_t)(u.pm * 256 + rit) * 1536;
#pragma unroll
                for (int bj = 0; bj < 2; ++bj) { const int c0 = u.pn * 256 + bj * 128 + wc * 32 + 8 * fq; const int cc = c0 % 192;
                    f32x4 v0 = acc[ai][bj][m][0], v1 = acc[ai][bj][m][1];
                    if (cc >= 128 && latent) { const int i0 = (cc - 128) >> 1; const int ro = ((i0 & 16) ? 256 + (t & 63) : (t >> 6)) * 16 + (i0 & 15); const f32x4 c4 = *(const GAS f32x4*)(cs + ro), s4 = *(const GAS f32x4*)(sn + ro);
                        f32x4 a0, a1; a0[0] = v0[0] * c4[0] - v0[1] * s4[0]; a0[1] = v0[0] * s4[0] + v0[1] * c4[0]; a0[2] = v0[2] * c4[1] - v0[3] * s4[1]; a0[3] = v0[2] * s4[1] + v0[3] * c4[1];
                        a1[0] = v1[0] * c4[2] - v1[1] * s4[2]; a1[1] = v1[0] * s4[2] + v1[1] * c4[2]; a1[2] = v1[2] * c4[3] - v1[3] * s4[3]; a1[3] = v1[2] * s4[3] + v1[3] * c4[3]; v0 = a0; v1 = a1; }
                    v0 = v0 * qscale; v1 = v1 * qscale;
                    *(GAS u32x4*)(rowp + c0) = pack8(v0, v1); } }
    }
};
constexpr int P1LD = 12288;
constexpr size_t P1PLANE = (size_t)MALL * 256;
struct EpiIn1 {
    static constexpr bool PERM = true;
    bf16* O; const float* cs; const float* sn; const float* rld;
    __device__ __forceinline__ void operator()(const f32x4 (&acc)[2][2][4][2], const GUnit& u, int wr, int wc, int fr, int fq) const {
        asm volatile("" : "+v"(fr), "+v"(fq));
        const int w = u.pm % 65; const bool latent = w < 64; const bool qk = u.pn < 16; const bool isk = u.pn >= 8; const bool rope = qk && latent; const float ks = (qk && isk) ? 0.0625f : 1.f;
        const int hd = u.pn & 7; float lgf = 0.f, lgb = 0.f; if (qk) { lgf = -__expf(rld[hd]); lgb = -__expf(rld[8 + hd]); if (isk) { lgf = -lgf; lgb = -lgb; } }
        const int plane = qk ? (isk ? 8 : 0) + hd : 24 + (u.pn - 16);
        const int rit0 = wr * 64 + fr;
#pragma unroll
        for (int ai = 0; ai < 2; ++ai)
#pragma unroll
            for (int m = 0; m < 4; ++m) { const int rit = rit0 + ai * 128 + m * 16; const int t = w * 256 + rit; const int p = rit & 127;
                bf16* rowp = O + ((size_t)plane * MALL + (size_t)(u.pm * 256 + rit)) * 256 + wc * 32 + 8 * fq;
                const float ff = qk ? __expf(lgf * (float)(p + 1)) : 1.f, fb = qk ? __expf(lgb * (float)(128 - p)) : 1.f;
#pragma unroll
                for (int bj = 0; bj < 2; ++bj) { f32x4 v0 = acc[ai][bj][m][0], v1 = acc[ai][bj][m][1];
                    if (rope) { const int i0 = 64 * bj + 16 * wc + 4 * fq; const int ro = (bj ? 256 + (t & 63) : (t >> 6)) * 64 + (i0 & 63); const f32x4 c4 = *(const GAS f32x4*)(cs + ro), s4 = *(const GAS f32x4*)(sn + ro);
                        f32x4 a0, a1; a0[0] = v0[0] * c4[0] - v0[1] * s4[0]; a0[1] = v0[0] * s4[0] + v0[1] * c4[0]; a0[2] = v0[2] * c4[1] - v0[3] * s4[1]; a0[3] = v0[2] * s4[1] + v0[3] * c4[1];
                        a1[0] = v1[0] * c4[2] - v1[1] * s4[2]; a1[1] = v1[0] * s4[2] + v1[1] * c4[2]; a1[2] = v1[2] * c4[3] - v1[3] * s4[3]; a1[3] = v1[2] * s4[3] + v1[3] * c4[3]; v0 = a0; v1 = a1; }
                    v0 = v0 * ks; v1 = v1 * ks;
                    if (qk) { *(GAS u32x4*)(rowp + bj * 128) = pack8(v0 * ff, v1 * ff); if (isk) *(GAS u32x4*)(rowp + 8 * P1PLANE + bj * 128) = pack8(v0 * fb, v1 * fb); }
                    else *(GAS u32x4*)(rowp + bj * 128) = pack8(v0, v1); } }
    }
};
struct EpiResid {
    static constexpr bool PERM = false;
    const float* srcLat; const float* srcCtx; float* dstLat; float* dstCtx; const float* gate; float sc = 1.f;
    __device__ __forceinline__ void operator()(const f32x4 (&acc)[2][2][4][2], const GUnit& u, int wr, int wc, int fr, int fq) const {
        asm volatile("" : "+v"(fr), "+v"(fq));
        const int b = u.pm / 65, w = u.pm % 65; const float* src; float* dst; int set;
        if (w < 64) { const size_t o = ((size_t)b * T + (size_t)w * 256) * D; src = srcLat + o; dst = dstLat + o; set = b; }
        else { const size_t o = (size_t)b * CTX * D; src = srcCtx + o; dst = dstCtx + o; set = 2; }
        const int col0 = u.pn * 256 + wc * 32 + 4 * fq; const float* g = gate + (size_t)set * 12288 + col0;
        f32x4 gv[2][2];
#pragma unroll
        for (int bj = 0; bj < 2; ++bj)
#pragma unroll
            for (int n = 0; n < 2; ++n) gv[bj][n] = *(const GAS f32x4*)(g + bj * 128 + n * 16) * sc;
#pragma unroll
        for (int ai = 0; ai < 2; ++ai)
#pragma unroll
            for (int m = 0; m < 4; ++m) { const size_t p = (size_t)(wr * 64 + fr + ai * 128 + m * 16) * D + col0;
#pragma unroll
                for (int bj = 0; bj < 2; ++bj)
#pragma unroll
                    for (int n = 0; n < 2; ++n) { const f32x4 bs = *(const GAS f32x4*)(src + p + bj * 128 + n * 16); *(GAS f32x4*)(dst + p + bj * 128 + n * 16) = bs + gv[bj][n] * acc[ai][bj][m][n]; } }
    }
};
struct EpiSwiGLU {
    static constexpr bool PERM = true;
    bf16* Hd; int ldc;
    __device__ __forceinline__ void operator()(const f32x4 (&acc)[2][2][4][2], const GUnit& u, int wr, int wc, int fr, int fq) const {
        asm volatile("" : "+v"(fr), "+v"(fq));
        const int row0 = u.pm * 256 + wr * 64 + fr, col0 = u.pn * 128 + wc * 32 + 8 * fq;
#pragma unroll
        for (int ai = 0; ai < 2; ++ai)
#pragma unroll
            for (int m = 0; m < 4; ++m) { f32x4 h0, h1;
#pragma unroll
                for (int j = 0; j < 4; ++j) { h0[j] = silu_f(acc[ai][0][m][0][j]) * acc[ai][1][m][0][j]; h1[j] = silu_f(acc[ai][0][m][1][j]) * acc[ai][1][m][1][j]; }
                *(GAS u32x4*)(Hd + (size_t)(row0 + ai * 128 + m * 16) * ldc + col0) = pack8(h0, h1); }
    }
};

__device__ __forceinline__ float clamp448(float x) { return __builtin_amdgcn_fmed3f(x, -448.f, 448.f); }
__device__ __forceinline__ unsigned pack4_fp8(float a, float b, float c, float d) { int w = __builtin_amdgcn_cvt_pk_fp8_f32(clamp448(a), clamp448(b), 0, false); w = __builtin_amdgcn_cvt_pk_fp8_f32(clamp448(c), clamp448(d), w, true); return (unsigned)w; }
constexpr float W8_SCALE = 256.f;
constexpr float H8_SCALE = 8.f;
struct EpiSwiGLUto8 {
    static constexpr bool PERM = true;
    unsigned char* Hd; int ldc;
    __device__ __forceinline__ void operator()(const f32x4 (&acc)[2][2][4][2], const GUnit& u, int wr, int wc, int fr, int fq) const {
        asm volatile("" : "+v"(fr), "+v"(fq));
        const int row0 = u.pm * 256 + wr * 64 + fr, col0 = u.pn * 128 + wc * 32 + 8 * fq;
#pragma unroll
        for (int ai = 0; ai < 2; ++ai)
#pragma unroll
            for (int m = 0; m < 4; ++m) { f32x4 h0, h1;
#pragma unroll
                for (int j = 0; j < 4; ++j) { h0[j] = silu_f(acc[ai][0][m][0][j]) * (acc[ai][1][m][0][j] * H8_SCALE); h1[j] = silu_f(acc[ai][0][m][1][j]) * (acc[ai][1][m][1][j] * H8_SCALE); }
                u32x2 w; w.x = pack4_fp8(h0[0], h0[1], h0[2], h0[3]); w.y = pack4_fp8(h1[0], h1[1], h1[2], h1[3]);
                *(GAS u32x2*)(Hd + (size_t)(row0 + ai * 128 + m * 16) * ldc + col0) = w; }
    }
};
struct EpiSwiGLU8 {
    static constexpr bool PERM = true;
    unsigned char* Hd; int ldc;
    __device__ __forceinline__ void operator()(const f32x4 (&acc)[2][2][4][2], const GUnit& u, int wr, int wc, int fr, int fq) const {
        asm volatile("" : "+v"(fr), "+v"(fq));
        const int row0 = u.pm * 256 + wr * 64 + fr, col0 = u.pn * 128 + wc * 32 + 8 * fq; constexpr float si = 1.f / W8_SCALE;
#pragma unroll
        for (int ai = 0; ai < 2; ++ai)
#pragma unroll
            for (int m = 0; m < 4; ++m) { f32x4 h0, h1;
#pragma unroll
                for (int j = 0; j < 4; ++j) { h0[j] = silu_f(acc[ai][0][m][0][j] * si) * (acc[ai][1][m][0][j] * (si * H8_SCALE)); h1[j] = silu_f(acc[ai][0][m][1][j] * si) * (acc[ai][1][m][1][j] * (si * H8_SCALE)); }
                u32x2 w; w.x = pack4_fp8(h0[0], h0[1], h0[2], h0[3]); w.y = pack4_fp8(h1[0], h1[1], h1[2], h1[3]);
                *(GAS u32x2*)(Hd + (size_t)(row0 + ai * 128 + m * 16) * ldc + col0) = w; }
    }
};

#define XB_TMO      128
#define XB_XCNT(j)  (256  + 64 * (j))
#define XB_XSUB(j)  (1280 + 64 * (j))
#define XB_XGEN(j)  (2304 + 64 * (j))
#define XB_TOP      3328
#define XB_TOPGEN   3392
#define XCD_BAR_WORDS 3456
#define XB_SPIN_CAP (1u << 18)
__device__ __forceinline__ unsigned xb_ld(unsigned* p)              { return __hip_atomic_load(p, __ATOMIC_RELAXED, __HIP_MEMORY_SCOPE_AGENT); }
__device__ __forceinline__ unsigned xb_add(unsigned* p, unsigned v) { return __hip_atomic_fetch_add(p, v, __ATOMIC_RELAXED, __HIP_MEMORY_SCOPE_AGENT); }
__device__ __forceinline__ unsigned xb_xcc_id() { return (unsigned)__builtin_amdgcn_s_getreg((3 << 11) | 20) & 0xFu; }
#define XB_SPIN_TIGHT(cond, bar) do { unsigned _sp = 0; while (cond) { \
    if ((++_sp & 255u) == 0u) { if (xb_ld(&(bar)[XB_TMO])) break; if (_sp > XB_SPIN_CAP) { atomicAdd(&(bar)[XB_TMO], 1u); break; } } } } while (0)
#define XB_SPIN(cond, bar) do { unsigned _sp = 0; while (cond) { __builtin_amdgcn_s_sleep(1); \
    if ((++_sp & 255u) == 0u) { if (xb_ld(&(bar)[XB_TMO])) break; if (_sp > XB_SPIN_CAP) { atomicAdd(&(bar)[XB_TMO], 1u); break; } } } } while (0)
struct XcdBarrier { unsigned* bar; unsigned x; volatile LAS unsigned* st; };
__device__ __forceinline__ XcdBarrier xcd_barrier_post(unsigned* bar, volatile LAS unsigned* st) {
    XcdBarrier b; b.bar = bar; b.x = xb_xcc_id(); b.st = st;
    if (threadIdx.x == 0) (void)xb_add(&bar[XB_XCNT(b.x)], 1u);
    return b;
}
__device__ __forceinline__ void xcd_barrier_complete(unsigned* bar, unsigned x, unsigned& nloc, unsigned& nx) {
    const unsigned G = gridDim.x * gridDim.y * gridDim.z;
    unsigned sum, cnt, mine, sp = 0u;
    for (;;) {
        sum = 0u; cnt = 0u; mine = 0u;
#pragma unroll
        for (unsigned j = 0; j < 16; ++j) { const unsigned c = xb_ld(&bar[XB_XCNT(j)]); sum += c; cnt += (c > 0u) ? 1u : 0u; mine = (j == x) ? c : mine; }
        if (sum == G) break;
        __builtin_amdgcn_s_sleep(1);
        if ((++sp & 255u) == 0u) { if (xb_ld(&bar[XB_TMO])) break; if (sp > XB_SPIN_CAP) { atomicAdd(&bar[XB_TMO], 1u); break; } }
    }
    nloc = mine > 0u ? mine : 1u; nx = cnt > 0u ? cnt : 1u;
}
__device__ __forceinline__ void xcd_barrier(const XcdBarrier& b) {
    asm volatile("s_waitcnt vmcnt(0)" ::: "memory");
    __syncthreads();
    if (threadIdx.x == 0) {
        unsigned* bar = b.bar;
        __builtin_amdgcn_s_waitcnt(0);
        unsigned nloc = b.st[0], nx = b.st[1];
        if (nloc == 0u) { xcd_barrier_complete(bar, b.x, nloc, nx); b.st[0] = nloc; b.st[1] = nx; }
        const unsigned old = xb_add(&bar[XB_XSUB(b.x)], 1u);
        const unsigned gen = old / nloc;
        if (old + 1u == (gen + 1u) * nloc) {
            __builtin_amdgcn_fence(__ATOMIC_RELEASE, "agent");
            asm volatile("s_waitcnt vmcnt(0)" ::: "memory");
            const unsigned og = xb_add(&bar[XB_TOP], 1u);
            const unsigned tg = og / nx;
            if (og + 1u == (tg + 1u) * nx) xb_add(&bar[XB_TOPGEN], 1u);
            else XB_SPIN_TIGHT(xb_ld(&bar[XB_TOPGEN]) == tg, bar);
            __builtin_amdgcn_fence(__ATOMIC_ACQUIRE, "agent");
            xb_add(&bar[XB_XGEN(b.x)], 1u);
            asm volatile("s_waitcnt vmcnt(0)" ::: "memory");
        } else {
            XB_SPIN(xb_ld(&bar[XB_XGEN(b.x)]) == gen, bar);
            __builtin_amdgcn_fence(__ATOMIC_ACQUIRE, "agent");
            asm volatile("s_waitcnt vmcnt(0)" ::: "memory");
        }
    }
    __syncthreads();
}

__device__ __forceinline__ int v_st(int k, int c) { const int kk = (k & ~0xC) | ((k & 4) << 1) | ((k & 8) >> 1); return ((kk >> 3) * 4 + (c >> 5)) * 512 + ((kk & 7) * 32 + (c & 31)) * 2; }
__device__ __forceinline__ int v_rd_base(int lane) { return ((lane & 3) << 3) | (((lane >> 2) & 3) << 6) | (((lane >> 4) & 1) << 5) | (((lane >> 5) & 1) << 8); }
constexpr int v_rd_off(int d0, int ks, int half) { return d0 * 512 + ks * 4096 + half * 2048; }
template <int OFF> __device__ __forceinline__ s16x4 tr_read(int vb) { s16x4 r; asm volatile("ds_read_b64_tr_b16 %0, %1 offset:%2" : "=&v"(r) : "v"(vb), "i"(OFF) : "memory"); return r; }
#define PK8(L, H) (bf16x8){L[0], L[1], L[2], L[3], H[0], H[1], H[2], H[3]}
#define PK4(P, BASE, OUT) do { unsigned a0_ = cvtpk(P[BASE + 0], P[BASE + 1]), a1_ = cvtpk(P[BASE + 2], P[BASE + 3]);   \
    unsigned b0_ = cvtpk(P[BASE + 4], P[BASE + 5]), b1_ = cvtpk(P[BASE + 6], P[BASE + 7]);                              \
    auto r0_ = __builtin_amdgcn_permlane32_swap(a0_, b0_, false, false); auto r1_ = __builtin_amdgcn_permlane32_swap(a1_, b1_, false, false); \
    u32x4 w_ = {r0_[0], r1_[0], r0_[1], r1_[1]}; OUT = __builtin_bit_cast(bf16x8, w_); } while (0)
template <int D0> __device__ __forceinline__ void pv_one(f32x16& od, int vb, bf16x8 pa0, bf16x8 pa1, bf16x8 pa2, bf16x8 pa3) {
    const s16x4 l0 = tr_read<v_rd_off(D0, 0, 0)>(vb), h0 = tr_read<v_rd_off(D0, 0, 1)>(vb), l1 = tr_read<v_rd_off(D0, 1, 0)>(vb), h1 = tr_read<v_rd_off(D0, 1, 1)>(vb);
    const s16x4 l2 = tr_read<v_rd_off(D0, 2, 0)>(vb), h2 = tr_read<v_rd_off(D0, 2, 1)>(vb), l3 = tr_read<v_rd_off(D0, 3, 0)>(vb), h3 = tr_read<v_rd_off(D0, 3, 1)>(vb);
    asm volatile("s_waitcnt lgkmcnt(0)" ::: "memory"); SBAR();
    od = __builtin_amdgcn_mfma_f32_32x32x16_bf16(pa0, PK8(l0, h0), od, 0, 0, 0);
    od = __builtin_amdgcn_mfma_f32_32x32x16_bf16(pa1, PK8(l1, h1), od, 0, 0, 0);
    od = __builtin_amdgcn_mfma_f32_32x32x16_bf16(pa2, PK8(l2, h2), od, 0, 0, 0);
    od = __builtin_amdgcn_mfma_f32_32x32x16_bf16(pa3, PK8(l3, h3), od, 0, 0, 0);
}
__device__ __forceinline__ void pv_d0(f32x16* o, int vb, bf16x8 pa0, bf16x8 pa1, bf16x8 pa2, bf16x8 pa3) {
    pv_one<0>(o[0], vb, pa0, pa1, pa2, pa3); pv_one<1>(o[1], vb, pa0, pa1, pa2, pa3); pv_one<2>(o[2], vb, pa0, pa1, pa2, pa3); pv_one<3>(o[3], vb, pa0, pa1, pa2, pa3);
}


__device__ __forceinline__ void otile_write(LAS unsigned char* wbase, const f32x16* o, int r32, int hi) {
    LAS float* p = (LAS float*)wbase + (4 * hi) * 128 + r32;
#pragma unroll
    for (int d = 0; d < 4; ++d)
#pragma unroll
        for (int r = 0; r < 16; ++r) p[((r & 3) + 8 * (r >> 2)) * 128 + 32 * d] = o[d][r];
}

__device__ __forceinline__ void scan_vimg_kc(int tid, int (&kc)[2]) {
#pragma unroll
    for (int i = 0; i < 2; ++i) { const int o = (i * 8 + (tid >> 6)) * 1024 + (tid & 63) * 16; const int st = o >> 9, w = (o & 511) >> 1; const int kk = (st >> 2) * 8 + (w >> 5), c = (st & 3) * 32 + (w & 31);
        const int k = (kk & ~0xC) | ((kk & 4) << 1) | ((kk & 8) >> 1); kc[i] = (k << 8) | c; }
}

namespace mla {
constexpr int KSTR = 400, KT_BYTES = 64 * KSTR, VT_BYTES = 16384, STAGE_BYTES = VT_BYTES + KT_BYTES;
constexpr int L_WS = 3 * STAGE_BYTES, L_END = L_WS + 8 * 64 * 4;
static_assert(L_END <= 131072, "attention LDS map");
constexpr float THR = 8.f;
__device__ __forceinline__ void partialSM(f32x16& p0, f32x16& p1, float& m_reg, float& mn, float& alpha) {
    float pmax = p0[0];
#pragma unroll
    for (int r = 1; r < 16; ++r) pmax = fmaxf(pmax, p0[r]);
#pragma unroll
    for (int r = 0; r < 16; ++r) pmax = fmaxf(pmax, p1[r]);
    { auto rr = __builtin_amdgcn_permlane32_swap(__float_as_uint(pmax), __float_as_uint(pmax), false, false); pmax = fmaxf(__uint_as_float(rr[0]), __uint_as_float(rr[1])); }
    if (__builtin_expect(__all(pmax - m_reg <= THR), 1)) { mn = m_reg; alpha = 1.f; }
    else { mn = fmaxf(m_reg, pmax); alpha = __builtin_amdgcn_exp2f(m_reg - mn); m_reg = mn; }
#pragma unroll
    for (int r = 0; r < 16; ++r) p0[r] = p0[r] - mn;
#pragma unroll
    for (int r = 0; r < 16; ++r) p1[r] = p1[r] - mn;
#pragma unroll
    for (int r = 0; r < 16; ++r) p0[r] = __builtin_amdgcn_exp2f(p0[r]);
}
__device__ __forceinline__ void finishSM(f32x16& p0, f32x16& p1, float alpha, float& l_reg, bf16x8& pa0, bf16x8& pa1, bf16x8& pa2, bf16x8& pa3) {
#pragma unroll
    for (int r = 0; r < 16; ++r) p1[r] = __builtin_amdgcn_exp2f(p1[r]);
    float ps = 0;
#pragma unroll
    for (int r = 0; r < 16; ++r) ps += p0[r];
#pragma unroll
    for (int r = 0; r < 16; ++r) ps += p1[r];
    { auto rr = __builtin_amdgcn_permlane32_swap(__float_as_uint(ps), __float_as_uint(ps), false, false); ps = __uint_as_float(rr[0]) + __uint_as_float(rr[1]); }
    l_reg = l_reg * alpha + ps;
    PK4(p0, 0, pa0); PK4(p0, 8, pa1); PK4(p1, 0, pa2); PK4(p1, 8, pa3);
}
__device__ __forceinline__ void qkt(f32x16& p0, f32x16& p1, const LAS unsigned char* Ks, const bf16x8* qr, int r32, int hi) {
    p0 = f32x16{}; p1 = f32x16{};
    const LAS unsigned char* kb = Ks + r32 * KSTR + hi * 16;
#pragma unroll
    for (int d0 = 0; d0 < 12; ++d0) {
        const bf16x8 b0 = *(const LAS bf16x8*)(kb + d0 * 32);
        const bf16x8 b1 = *(const LAS bf16x8*)(kb + 32 * KSTR + d0 * 32);
        p0 = __builtin_amdgcn_mfma_f32_32x32x16_bf16(b0, qr[d0], p0, 0, 0, 0);
        p1 = __builtin_amdgcn_mfma_f32_32x32x16_bf16(b1, qr[d0], p1, 0, 0, 0); }
}
__device__ __forceinline__ void qkt_negm(f32x16& p0, f32x16& p1, const LAS unsigned char* Ks, const bf16x8* qr, float negm, int r32, int hi) {
#pragma unroll
    for (int r = 0; r < 16; ++r) { p0[r] = negm; p1[r] = negm; }
    const LAS unsigned char* kb = Ks + r32 * KSTR + hi * 16;
#pragma unroll
    for (int d0 = 0; d0 < 12; ++d0) {
        const bf16x8 b0 = *(const LAS bf16x8*)(kb + d0 * 32);
        const bf16x8 b1 = *(const LAS bf16x8*)(kb + 32 * KSTR + d0 * 32);
        p0 = __builtin_amdgcn_mfma_f32_32x32x16_bf16(b0, qr[d0], p0, 0, 0, 0);
        p1 = __builtin_amdgcn_mfma_f32_32x32x16_bf16(b1, qr[d0], p1, 0, 0, 0); }
}
__device__ __forceinline__ void partialSM_negm(f32x16& p0, f32x16& p1, float& m_reg, float& alpha) {
    float pmax = p0[0];
#pragma unroll
    for (int r = 1; r < 16; ++r) pmax = fmaxf(pmax, p0[r]);
#pragma unroll
    for (int r = 0; r < 16; ++r) pmax = fmaxf(pmax, p1[r]);
    { auto rr = __builtin_amdgcn_permlane32_swap(__float_as_uint(pmax), __float_as_uint(pmax), false, false); pmax = fmaxf(__uint_as_float(rr[0]), __uint_as_float(rr[1])); }
    if (__builtin_expect(__all(pmax <= THR), 1)) { alpha = 1.f; }
    else { const float d = fmaxf(pmax, 0.f); alpha = __builtin_amdgcn_exp2f(-d); m_reg += d;
#pragma unroll
        for (int r = 0; r < 16; ++r) { p0[r] -= d; p1[r] -= d; } }
#pragma unroll
    for (int r = 0; r < 16; ++r) p0[r] = __builtin_amdgcn_exp2f(p0[r]);
}
__device__ __forceinline__ int slot_off(int t) { int so = (t % 3) * STAGE_BYTES; asm volatile("" : "+s"(so)); return so; }
__device__ __forceinline__ void attn_unit(const bf16* __restrict__ Qb, const bf16* __restrict__ Kn, const bf16* __restrict__ Vh, const bf16* __restrict__ Kr, bf16* __restrict__ Ob, int nkeys, LAS unsigned char* lds) {
    const int tid = threadIdx.x, wid = __builtin_amdgcn_readfirstlane(tid >> 6), lane = tid & 63, r32 = lane & 31, hi = lane >> 5;
    LAS float* ws = (LAS float*)(lds + L_WS) + wid * 64; LAS float* li_l = ws; LAS float* al_l = ws + 32;
    float m_reg = -1e30f, l_reg = 0; f32x16 o[4] = {}; bf16x8 qr[12];
    const bf16* Qw = Qb + (size_t)(wid * 32 + r32) * 1536 + hi * 8;
#pragma unroll
    for (int d0 = 0; d0 < 12; ++d0) qr[d0] = *(const bf16x8*)(Qw + d0 * 16);
    int kc[2]; scan_vimg_kc(tid, kc);
    const int lbase = (int)(uintptr_t)lds + v_rd_base(lane);
    int pk[4];
#pragma unroll
    for (int i = 0; i < 4; ++i) { const int idx = (wid + 8 * i) * 64 + lane; pk[i] = ((idx / 25) << 8) | (idx % 25); }
#define DMA_TILE(t) do { const int t_ = (t); const int so_ = slot_off(t_); const size_t k0_ = (size_t)t_ * 64; \
    _Pragma("unroll") for (int i_ = 0; i_ < 2; ++i_) __builtin_amdgcn_global_load_lds((const unsigned*)(Vh + (k0_ + (kc[i_] >> 8)) * 2048 + (kc[i_] & 255)), (LAS unsigned*)(lds + so_ + (i_ * 8 + wid) * 1024), 16, 0, 0); \
    _Pragma("unroll") for (int i_ = 0; i_ < 4; ++i_) if (i_ < 3 || wid == 0) { const int row_ = pk[i_] >> 8, c_ = pk[i_] & 255; \
        const bf16* src_ = (c_ < 16) ? (Kn + (k0_ + row_) * 2048 + c_ * 8) : (c_ < 24 ? (Kr + (k0_ + row_) * 64 + (c_ - 16) * 8) : Kn); \
        __builtin_amdgcn_global_load_lds((const unsigned*)src_, (LAS unsigned*)(lds + so_ + VT_BYTES + (wid + 8 * i_) * 1024), 16, 0, 0); } } while (0)
#define KSLOT(t) (lds + slot_off(t) + VT_BYTES)
#define VSLOT(t) (lbase + slot_off(t))
#define RESC(a) do { if (__any((a) < 1.f)) { if (hi == 0) al_l[r32] = (a); asm volatile("s_waitcnt lgkmcnt(0)" ::: "memory"); \
    _Pragma("unroll") for (int d = 0; d < 4; ++d) _Pragma("unroll") for (int r = 0; r < 16; ++r) o[d][r] *= al_l[crow(r, hi)]; } } while (0)
    f32x16 pA0, pA1, pB0, pB1; float mnA, mnB, alA, alB; bf16x8 pa0, pa1, pa2, pa3; const int NTI = nkeys / 64;
    __syncthreads();
    DMA_TILE(0); DMA_TILE(1); VM_WAIT(); __syncthreads();
    qkt(pA0, pA1, KSLOT(0), qr, r32, hi); partialSM(pA0, pA1, m_reg, mnA, alA);
    if (2 < NTI) DMA_TILE(2);
    for (int j = 1; j + 1 < NTI; j += 2) {
        qkt_negm(pB0, pB1, KSLOT(j), qr, -m_reg, r32, hi);
        finishSM(pA0, pA1, alA, l_reg, pa0, pa1, pa2, pa3);
        pv_d0(o, VSLOT(j - 1), pa0, pa1, pa2, pa3); partialSM_negm(pB0, pB1, m_reg, alB);
        VM_WAIT(); __syncthreads();
        if (j + 2 < NTI) DMA_TILE(j + 2);
        RESC(alB);
        qkt_negm(pA0, pA1, KSLOT(j + 1), qr, -m_reg, r32, hi);
        finishSM(pB0, pB1, alB, l_reg, pa0, pa1, pa2, pa3);
        pv_d0(o, VSLOT(j), pa0, pa1, pa2, pa3); partialSM_negm(pA0, pA1, m_reg, alA);
        VM_WAIT(); __syncthreads();
        if (j + 3 < NTI) DMA_TILE(j + 3);
        RESC(alA);
    }
    qkt_negm(pB0, pB1, KSLOT(NTI - 1), qr, -m_reg, r32, hi);
    finishSM(pA0, pA1, alA, l_reg, pa0, pa1, pa2, pa3);
    pv_d0(o, VSLOT(NTI - 2), pa0, pa1, pa2, pa3); partialSM_negm(pB0, pB1, m_reg, alB);
    RESC(alB);
    finishSM(pB0, pB1, alB, l_reg, pa0, pa1, pa2, pa3);
    pv_d0(o, VSLOT(NTI - 1), pa0, pa1, pa2, pa3);
    if (hi == 0) li_l[r32] = l_reg; asm volatile("s_waitcnt lgkmcnt(0)" ::: "memory");
#pragma unroll
    for (int r = 0; r < 16; ++r) { const float rl = __builtin_amdgcn_rcpf(li_l[crow(r, hi)]);
#pragma unroll
        for (int d0 = 0; d0 < 4; ++d0) o[d0][r] *= rl; }
    __syncthreads();
    int le = lane; asm volatile("" : "+v"(le));
    LAS unsigned char* wb = lds + wid * 16384;
    otile_write(wb, o, le & 31, le >> 5);
    asm volatile("s_waitcnt lgkmcnt(0)" ::: "memory");
    { const int rr0 = le >> 4, c8 = (le & 15) * 8; bf16* Ow = Ob + (size_t)(wid * 32 + rr0) * 2048 + c8; const LAS float* rp = (const LAS float*)wb + rr0 * 128 + c8;
#pragma unroll
      for (int it = 0; it < 8; ++it) { const f32x4 a = *(const LAS f32x4*)(rp + it * 512), b2 = *(const LAS f32x4*)(rp + it * 512 + 4);
          *(u32x4*)(Ow + (size_t)it * 4 * 2048) = pack8(a, b2); } }
#undef DMA_TILE
#undef KSLOT
#undef VSLOT
#undef RESC
}
}

namespace scan {
template <int D0, int KS> __device__ __forceinline__ void vfrag_issue(int vb, s16x4& l, s16x4& h) { l = tr_read<v_rd_off(D0, KS, 0)>(vb); h = tr_read<v_rd_off(D0, KS, 1)>(vb); }
using ::scan_vimg_kc;
__device__ __forceinline__ void vimg_kc(int tid, int (&kc)[2]) { scan_vimg_kc(tid, kc); }
__device__ __forceinline__ void dma_vimage(LAS unsigned char* lds, int img_off, const bf16* g, int ld, const int (&kc)[2], int wid) {
#pragma unroll
    for (int i = 0; i < 2; ++i) __builtin_amdgcn_global_load_lds((const unsigned*)(g + (size_t)(kc[i] >> 8) * ld + (kc[i] & 255)), (LAS unsigned*)(lds + img_off + (i * 8 + wid) * 1024), 16, 0, 0);
}
template <int DK> __device__ __forceinline__ void dma_ktile(LAS unsigned char* lds, int off, const bf16* g, int ld, int wid, int lane) {
    constexpr int KSTRB = DK * 2 + 16, NI = 64 * KSTRB / 1024;
    for (int j = wid; j < NI; j += 8) { const int o = j * 1024 + lane * 16; const int row = o / KSTRB; int ch = (o % KSTRB) >> 4; ch = (ch == DK / 8) ? 0 : ch;
        __builtin_amdgcn_global_load_lds((const unsigned*)(g + (size_t)row * ld + ch * 8), (LAS unsigned*)(lds + off + j * 1024), 16, 0, 0); }
}

template <bool SW> __device__ __forceinline__ void blk32_store(LAS unsigned char* stg, const f32x16& v, bf16* g, int ld, int lane) {
    const int r32 = lane & 31, hi = lane >> 5;
    LAS unsigned short* w = (LAS unsigned short*)(stg + (4 * hi) * 80 + r32 * 2);
#pragma unroll
    for (int r = 0; r < 16; r += 2) { const int ro = ((r & 3) + 8 * (r >> 2)) * 40;
        if (SW) { w[ro] = (unsigned short)f2bf_sw(v[r]); w[ro + 40] = (unsigned short)f2bf_sw(v[r + 1]); }
        else { const unsigned pk = cvtpk(v[r], v[r + 1]); w[ro] = (unsigned short)(pk & 0xffffu); w[ro + 40] = (unsigned short)(pk >> 16); } }
#pragma unroll
    for (int j = 0; j < 2; ++j) { const int idx = lane + 64 * j, row = idx >> 2, seg = idx & 3;
        const u32x4 o = *(const LAS u32x4*)(stg + row * 80 + seg * 16);
        *(GAS u32x4*)((GAS bf16*)g + (size_t)row * ld + seg * 8) = o; }
}
struct Src {
    const bf16* q0; const bf16* q1; const bf16* k0; const bf16* k1; const bf16* v; int ldq, ldk, ldv; size_t hsq, hsv  ; int H; bf16* ws; const float* egla; const float* rld;
};
__device__ __forceinline__ int chunk_of(int s, int dir) { return dir ? (NCH - 1 - s) : (s < 2 ? (NCH - 2 + s) : s - 2); }

template <int DK, int KS> __device__ __forceinline__ void a_step(f32x16* acc, int vbK, int vbV) {
    s16x4 bl, bh; vfrag_issue<0, KS>(vbV, bl, bh);
    s16x4 al[DK / 32], ah[DK / 32];
#pragma unroll
    for (int i = 0; i < DK / 32; ++i) { const int vbi = vbK + (i >> 2) * 16384; if ((i & 3) == 0) vfrag_issue<0, KS>(vbi, al[i], ah[i]); else if ((i & 3) == 1) vfrag_issue<1, KS>(vbi, al[i], ah[i]); else if ((i & 3) == 2) vfrag_issue<2, KS>(vbi, al[i], ah[i]); else vfrag_issue<3, KS>(vbi, al[i], ah[i]); }
    asm volatile("s_waitcnt lgkmcnt(0)" ::: "memory"); SBAR();
    const bf16x8 bfr = PK8(bl, bh);
#pragma unroll
    for (int i = 0; i < DK / 32; ++i) acc[i] = __builtin_amdgcn_mfma_f32_32x32x16_bf16(PK8(al[i], ah[i]), bfr, acc[i], 0, 0, 0);
}
template <int DK> __device__ __forceinline__ void phaseA(const Src& S, LAS unsigned char* lds, int G, int vcu) {
    const int tid = threadIdx.x, wid = __builtin_amdgcn_readfirstlane(tid >> 6), lane = tid & 63, r32 = lane & 31, hi = lane >> 5;
    constexpr int KH = DK / 128;
    constexpr int SLOT = (KH + 2) * 16384;
    static_assert(2 * SLOT <= SCR_BYTES, "scan phase A ring");
    int kc[2]; vimg_kc(tid, kc);
    const int nunits = NB * S.H * 2 * NCH;
    const int nmine = (nunits - vcu + G - 1) / G;
    const int nst = 2 * nmine;
    const int base = (int)(uintptr_t)lds + v_rd_base(lane);
#define A_DMA(g) do { const int g_ = (g); const int u_ = vcu + (g_ >> 1) * G, tt_ = g_ & 1; const int sq_ = u_ / NCH, cid_ = u_ % NCH, dir_ = sq_ & 1, bh_ = sq_ >> 1, b_ = bh_ / S.H, h_ = bh_ % S.H; \
        const size_t row_ = (size_t)b_ * SA + (size_t)cid_ * 128 + tt_ * 64; const bf16* kp_ = (dir_ ? S.k1 : S.k0) + row_ * S.ldk + h_ * S.hsq; const bf16* vp_ = S.v + row_ * S.ldv + h_ * S.hsv; const int so_ = (g_ & 1) * SLOT; \
        _Pragma("unroll") for (int im_ = 0; im_ < KH; ++im_) dma_vimage(lds, so_ + im_ * 16384, kp_ + im_ * 128, S.ldk, kc, wid); \
        _Pragma("unroll") for (int im_ = 0; im_ < 2; ++im_) dma_vimage(lds, so_ + (KH + im_) * 16384, vp_ + im_ * 128, S.ldv, kc, wid); } while (0)
    __syncthreads();
    if (nst > 0) A_DMA(0);
    f32x16 acc[DK / 32];
    for (int g = 0; g < nst; ++g) {
        VM_WAIT(); __syncthreads();
        if (g + 1 < nst) A_DMA(g + 1);
        const int tt = g & 1;
        if (tt == 0) {
#pragma unroll
            for (int i = 0; i < DK / 32; ++i) acc[i] = f32x16{}; }
        { int so = (g & 1) * SLOT; asm volatile("" : "+s"(so));
          const int vbK = base + so, vbV = base + so + (KH + (wid >> 2)) * 16384 + (wid & 3) * 512;
          a_step<DK, 0>(acc, vbK, vbV); a_step<DK, 1>(acc, vbK, vbV); a_step<DK, 2>(acc, vbK, vbV); a_step<DK, 3>(acc, vbK, vbV); }
        if (tt == 1) { const int u = vcu + (g >> 1) * G; const int sq = u / NCH, cid = u % NCH;
            bf16* Wp = S.ws + ((size_t)(sq * NCH + cid) * DK) * 256 + 32 * wid;
#pragma unroll
            for (int i = 0; i < DK / 32; ++i) blk32_store<true>(lds + 2 * SLOT + wid * 2560, acc[i], Wp + (size_t)(32 * i) * 256, 256, lane); }
    }
#undef A_DMA
}
template <int DK, bool RET, int PF = 4> __device__ __forceinline__ void phaseB(const Src& S, int G, int vcu, size_t dstoff = 0) {
    constexpr int NV = RET ? 2 : 1;
    const int nvec = NB * S.H * 2 * DK * 32; const int nthreads = G * NT; const int gt = vcu * NT + threadIdx.x;
    GAS bf16* base[NV]; const GAS float* ep[NV]; float eg[NV]; int dirv[NV]; bool on[NV];
#pragma unroll
    for (int q = 0; q < NV; ++q) { int v = gt + q * nthreads; on[q] = v < nvec; v = on[q] ? v : 0;
        const int sq = v / (DK * 32), rem = v % (DK * 32), i = rem >> 5, j8 = (rem & 31) * 8, dir = sq & 1, bh = sq >> 1, b = bh / S.H, h = bh % S.H;
        dirv[q] = dir; eg[q] = 1.f; if (RET) eg[q] = __expf(-__expf(S.rld[dir * 8 + h]) * 128.f);
        base[q] = (GAS bf16*)S.ws + ((size_t)sq * NCH * DK + i) * 256 + j8;
        ep[q] = RET ? nullptr : (const GAS float*)S.egla + ((size_t)(dir * 2 + b) * NCH) * 512 + h * 128 + i; }
    float st[NV][8]; u32x4 w[NV][PF]; float e[NV][PF];
#pragma unroll
    for (int q = 0; q < NV; ++q) {
#pragma unroll
        for (int j = 0; j < 8; ++j) st[q][j] = 0.f;
#pragma unroll
        for (int k = 0; k < PF; ++k) { const int c = chunk_of(k, dirv[q]); w[q][k] = on[q] ? *(const GAS u32x4*)(base[q] + (size_t)c * DK * 256) : (u32x4){0u, 0u, 0u, 0u}; e[q][k] = RET ? eg[q] : (on[q] ? ep[q][(size_t)c * 512] : 1.f); } }
    for (int s0 = 0; s0 < NCH; s0 += PF) {
#pragma unroll
        for (int k = 0; k < PF; ++k) { const int sidx = s0 + k;
            if (sidx < NCH) {
#pragma unroll
                for (int q = 0; q < NV; ++q) { const int c = chunk_of(sidx, dirv[q]);
                    u32x4 o;
#pragma unroll
                    for (int j = 0; j < 4; ++j) o[j] = cvtpk(st[q][2 * j], st[q][2 * j + 1]);
                    if (on[q]) *(GAS u32x4*)(base[q] + dstoff + (size_t)c * DK * 256) = o;
                    const float ee = e[q][k]; const u32x4 ww = w[q][k];
#pragma unroll
                    for (int j = 0; j < 4; ++j) { st[q][2 * j] = ee * (st[q][2 * j] + bflo(ww[j])); st[q][2 * j + 1] = ee * (st[q][2 * j + 1] + bfhi(ww[j])); }
                    if (sidx + PF < NCH) { const int cn = chunk_of(sidx + PF, dirv[q]); if (on[q]) { w[q][k] = *(const GAS u32x4*)(base[q] + (size_t)cn * DK * 256); if (!RET) e[q][k] = ep[q][(size_t)cn * 512]; } } } } }
    }
}
template <int OFF> __device__ __forceinline__ s16x4 tr_read_n(int vb) { s16x4 r; asm volatile("ds_read_b64_tr_b16 %0, %1 offset:%2" : "=&v"(r) : "v"(vb), "i"(OFF) : "memory"); return r; }
template <int KS> __device__ __forceinline__ void ab_step(f32x16& acc, int vbK, int vbV) {
    const s16x4 al = tr_read<v_rd_off(0, KS, 0)>(vbK), ah = tr_read<v_rd_off(0, KS, 1)>(vbK);
    const s16x4 bl = tr_read_n<KS * 2048>(vbV), bh = tr_read_n<KS * 2048 + 1024>(vbV);
    asm volatile("s_waitcnt lgkmcnt(0)" ::: "memory"); SBAR();
    acc = __builtin_amdgcn_mfma_f32_32x32x16_bf16(PK8(al, ah), PK8(bl, bh), acc, 0, 0, 0);
}
template <int DK, int MODE = 0> __device__ __forceinline__ void phaseAB(const Src& S, LAS unsigned char* lds, int G, int vcu) {
    static_assert(DK == 256, "fused carry pass: retention geometry");
    const int tid = threadIdx.x, wid = __builtin_amdgcn_readfirstlane(tid >> 6), lane = tid & 63, r32 = lane & 31, hi = lane >> 5, rb = wid >> 1, cb = wid & 1;
    constexpr int SLOT = 2 * 16384 + 2 * 8192;
    int kc[2]; vimg_kc(tid, kc);
    int vk[2];
#pragma unroll
    for (int i = 0; i < 2; ++i) { const int p = wid + 8 * i, tile = p >> 3, o = (p & 7) * 1024 + lane * 16; const int st = o >> 9, w = (o & 511) >> 1; const int kk = (st >> 1) * 8 + (w >> 5), c = (st & 1) * 32 + (w & 31);
        const int k = (kk & ~0xC) | ((kk & 4) << 1) | ((kk & 8) >> 1); vk[i] = (tile << 16) | (k << 8) | c; }
    const int base = (int)(uintptr_t)lds + v_rd_base(lane);
    const int ntasks = NB * S.H * 2 * 8;
    for (int task = vcu; task < ntasks; task += G) {
        const int sq = task >> 3, dkh = (task >> 2) & 1, dvq = task & 3, dir = sq & 1, bh = sq >> 1, b = bh / S.H, h = bh % S.H;
        const float eg = __expf(-__expf(S.rld[dir * 8 + h]) * 128.f);
        const bf16* kp = (dir ? S.k1 : S.k0) + (size_t)b * SA * S.ldk + h * S.hsq + dkh * 128; const bf16* vp = S.v + (size_t)b * SA * S.ldv + h * S.hsv + dvq * 64;
        bf16* sp = S.ws + ((size_t)sq * NCH * DK + dkh * 128 + 32 * rb) * 256 + dvq * 64 + 32 * cb;
#define AB_DMA(s_) do { const int c_ = chunk_of((s_), dir); const int so_ = ((s_) & 1) * SLOT; const size_t r0_ = (size_t)c_ * 128; \
        _Pragma("unroll") for (int tt_ = 0; tt_ < 2; ++tt_) dma_vimage(lds, so_ + tt_ * 16384, kp + (r0_ + tt_ * 64) * S.ldk, S.ldk, kc, wid); \
        _Pragma("unroll") for (int i_ = 0; i_ < 2; ++i_) __builtin_amdgcn_global_load_lds((const unsigned*)(vp + (r0_ + (vk[i_] >> 16) * 64 + ((vk[i_] >> 8) & 255)) * S.ldv + (vk[i_] & 255)), (LAS unsigned*)(lds + so_ + 32768 + (wid + 8 * i_) * 1024), 16, 0, 0); } while (0)
        f32x16 st = f32x16{};
        __syncthreads();
        AB_DMA(0);
        for (int s = 0; s < NCH; ++s) {
            if (s == 0) asm volatile("s_waitcnt vmcnt(0)" ::: "memory"); else asm volatile("s_waitcnt vmcnt(2)" ::: "memory");
            asm volatile("s_waitcnt lgkmcnt(0)" ::: "memory"); __builtin_amdgcn_s_barrier();
            if (!(MODE & 2)) { if (s + 1 < NCH) AB_DMA(s + 1); }
            const int c = chunk_of(s, dir);
            if (!(MODE & 1)) blk32_store<false>(lds + 2 * SLOT + wid * 2560, st, sp + (size_t)c * DK * 256, 256, lane);
            f32x16 acc = f32x16{};
            int so = (s & 1) * SLOT; asm volatile("" : "+s"(so));
#pragma unroll
            for (int tt = 0; tt < 2; ++tt) { const int vbK = base + so + tt * 16384 + rb * 512, vbV = base + so + 32768 + tt * 8192 + cb * 512;
                if (!(MODE & 4)) { ab_step<0>(acc, vbK, vbV); ab_step<1>(acc, vbK, vbV); ab_step<2>(acc, vbK, vbV); ab_step<3>(acc, vbK, vbV); } }
#pragma unroll
            for (int r = 0; r < 16; ++r) st[r] = eg * (st[r] + acc[r]);
        }
#undef AB_DMA
    }
}
template <int DK> __device__ __forceinline__ void qkt(f32x16& p0, f32x16& p1, const LAS unsigned char* Ks, const bf16x8* qr, int r32, int hi) {
    constexpr int KSTRB = DK * 2 + 16;
    p0 = f32x16{}; p1 = f32x16{};
#pragma unroll
    for (int d0 = 0; d0 < DK / 16; ++d0) { const int cb = (d0 * 16 + hi * 8) * 2;
        const bf16x8 b0 = *(const LAS bf16x8*)(Ks + r32 * KSTRB + cb);
        const bf16x8 b1 = *(const LAS bf16x8*)(Ks + (32 + r32) * KSTRB + cb);
        p0 = __builtin_amdgcn_mfma_f32_32x32x16_bf16(b0, qr[d0], p0, 0, 0, 0);
        p1 = __builtin_amdgcn_mfma_f32_32x32x16_bf16(b1, qr[d0], p1, 0, 0, 0); }
}
struct OutC { const bf16* gate; int ldg; const float* gain; bf16* mix; size_t hsg; };
template <int DK, bool RET, int MODE = 0> __device__ __forceinline__ void phaseC(const Src& S, const OutC& O, int nch_out, LAS unsigned char* lds, int G, int vcu) {
    const int tid = threadIdx.x, wid = __builtin_amdgcn_readfirstlane(tid >> 6), lane = tid & 63, r32 = lane & 31, hi = lane >> 5, qb = wid >> 1, dvh = wid & 1;
    constexpr int KSTRB = DK * 2 + 16, KT_BYTES = 64 * KSTRB, RED_OFF = 133120;
    constexpr bool EARLY = !RET;
    constexpr int SIMG = (DK / 64) * 2 * 16384, KT_OFF = EARLY ? SIMG : 0, VI_OFF = KT_OFF + 2 * KT_BYTES, VI2_OFF = EARLY ? 0 : VI_OFF + 32768;
    static_assert((EARLY ? VI_OFF + 32768 : VI_OFF + 65536) <= RED_OFF && SIMG <= RED_OFF && RED_OFF + 2048 <= SCR_BYTES, "scan phase C LDS map");
    int kc[2]; vimg_kc(tid, kc);
    const int nunits = NB * S.H * nch_out;
    const int lbase = (int)(uintptr_t)lds + v_rd_base(lane);
    bf16x8 qr[DK / 16];
#define PC_QLOAD(u_) do { const int cid_ = (u_) % nch_out, bh_ = (u_) / nch_out, b_ = bh_ / S.H, h_ = bh_ % S.H; \
        const GAS bf16* qp_ = (const GAS bf16*)S.q0 + ((size_t)b_ * SA + (size_t)cid_ * 128 + 32 * qb + r32) * S.ldq + h_ * S.hsq + hi * 8; \
        _Pragma("unroll") for (int d0 = 0; d0 < DK / 16; ++d0) qr[d0] = *(const GAS bf16x8*)(qp_ + d0 * 16); } while (0)
    if (vcu < nunits) PC_QLOAD(vcu);
    for (int u = vcu; u < nunits; u += G) {
        const int cid = u % nch_out, bh = u / nch_out, b = bh / S.H, h = bh % S.H;
        const size_t row0 = (size_t)b * SA + (size_t)cid * 128;
        const int tq = 32 * qb + r32;
        f32x16 o[4] = {};
#pragma unroll 1
        for (int dd = 0; dd < 2; ++dd) {
            const int dir = RET ? 1 - dd : dd;
            const int sq = bh * 2 + dir;
            const bool swapped = RET && dd == 1;
            const bf16* kp = ((dir && !RET) ? S.k1 : S.k0) + row0 * S.ldk + h * S.hsq; const bf16* vp = S.v + row0 * S.ldv + h * S.hsv;
#define PC_STATE() do { \
            __syncthreads(); \
            { const bf16* Sp = S.ws + ((size_t)(sq * NCH + cid) * DK) * 256; \
              _Pragma("unroll") for (int im = 0; im < (DK / 64) * 2; ++im) dma_vimage(lds, im * 16384, Sp + (size_t)(im >> 1) * 64 * 256 + (im & 1) * 128, 256, kc, wid); } \
            if (EARLY) { dma_ktile<DK>(lds, KT_OFF, kp, S.ldk, wid, lane); dma_ktile<DK>(lds, KT_OFF + KT_BYTES, kp + (size_t)64 * S.ldk, S.ldk, wid, lane); \
                _Pragma("unroll") for (int im = 0; im < 2; ++im) dma_vimage(lds, VI_OFF + im * 16384, vp + (size_t)(im & 1) * 128, S.ldv, kc, wid); } \
            if (!RET && dd == 1) { const bf16* qp = S.q1 + (row0 + tq) * S.ldq + h * S.hsq + hi * 8;     \
              _Pragma("unroll") for (int d0 = 0; d0 < DK / 16; ++d0) qr[d0] = *(const GAS bf16x8*)((const GAS bf16*)qp + d0 * 16); } \
            VM_WAIT(); __syncthreads(); \
            _Pragma("unroll") for (int tt = 0; tt < DK / 64; ++tt) pv_d0(o, lbase + (tt * 2 + dvh) * 16384, qr[4 * tt], qr[4 * tt + 1], qr[4 * tt + 2], qr[4 * tt + 3]); } while (0)
            if (!swapped) PC_STATE();
            if (!swapped) __syncthreads();
            if (swapped) {
            } else if (EARLY) {
#pragma unroll
                for (int im = 2; im < 4; ++im) dma_vimage(lds, VI2_OFF + (im - 2) * 16384, vp + (size_t)64 * S.ldv + (im & 1) * 128, S.ldv, kc, wid);
            } else {
              if (!(MODE & 2)) { dma_ktile<DK>(lds, KT_OFF, kp, S.ldk, wid, lane); dma_ktile<DK>(lds, KT_OFF + KT_BYTES, kp + (size_t)64 * S.ldk, S.ldk, wid, lane);
#pragma unroll
              for (int im = 0; im < 4; ++im) dma_vimage(lds, VI_OFF + im * 16384, vp + (size_t)(im >> 1) * 64 * S.ldv + (im & 1) * 128, S.ldv, kc, wid); }
              VM_WAIT(); __syncthreads(); }
#pragma unroll
            for (int kt = 0; kt < 2; ++kt) {
                const bool need = dir ? (64 * kt + 63 >= 32 * qb) : (64 * kt <= 32 * qb + 31);
                if (EARLY && kt == 1) { VM_WAIT(); __syncthreads(); }
                if (need) {
                    f32x16 p0, p1; qkt<DK>(p0, p1, lds + KT_OFF + kt * KT_BYTES, qr, r32, hi);
                    int tqv = tq - 4 * hi; asm volatile("" : "+v"(tqv));
                    if (RET && dd == 0) {
                        const float lf = -__expf(S.rld[h]) * 1.4426950408889634f, lb = -__expf(S.rld[8 + h]) * 1.4426950408889634f;
                        int hv = hi; asm volatile("" : "+v"(hv));
                        const float bb = lb + lf, a0 = (lf - 128.f * lb) + bb * (float)(64 * kt + 4 * hv);
#pragma unroll
                        for (int r = 0; r < 16; ++r) { const float ej = a0 + bb * (float)((r & 3) + 8 * (r >> 2));
                            p0[r] *= __builtin_amdgcn_exp2f(ej); p1[r] *= __builtin_amdgcn_exp2f(ej + 32.f * bb); } }
#pragma unroll
                    for (int r = 0; r < 16; ++r) { const int j0 = 64 * kt + (r & 3) + 8 * (r >> 2), j1 = j0 + 32;
                        const bool k0 = dir ? (j0 >= tqv) : (j0 <= tqv), k1 = dir ? (j1 >= tqv) : (j1 <= tqv);
                        p0[r] = k0 ? p0[r] : 0.f; p1[r] = k1 ? p1[r] : 0.f; }
                    bf16x8 pa0, pa1, pa2, pa3; PK4(p0, 0, pa0); PK4(p0, 8, pa1); PK4(p1, 0, pa2); PK4(p1, 8, pa3);
                    pv_d0(o, lbase + (kt == 0 ? VI_OFF : VI2_OFF) + dvh * 16384, pa0, pa1, pa2, pa3);
                }
            }
            if (swapped) PC_STATE();
            if (RET && dd == 0) {
                const float lf = -__expf(S.rld[h]) * 1.4426950408889634f, lb = -__expf(S.rld[8 + h]) * 1.4426950408889634f;
                int hv = hi; asm volatile("" : "+v"(hv));
                const float pp0 = (float)(32 * qb + 4 * hv); const float e0 = lb * (128.f - pp0) - lf * (pp0 + 1.f), de = -(lb + lf);
#pragma unroll
                for (int r = 0; r < 16; ++r) { const float sc_ = __builtin_amdgcn_exp2f(e0 + de * (float)((r & 3) + 8 * (r >> 2)));
#pragma unroll
                    for (int d = 0; d < 4; ++d) o[d][r] *= sc_; } }
        }
        LAS f32x2* red = (LAS f32x2*)(lds + RED_OFF);
        u32x4 gpre[8];
        { int ln = lane; asm volatile("" : "+v"(ln)); const int rr0 = ln >> 4, c8 = (ln & 15) * 8;
          const GAS bf16* gp = (const GAS bf16*)O.gate + (row0 + 32 * qb + rr0) * O.ldg + h * O.hsg + dvh * 128 + c8;
#pragma unroll
          for (int it = 0; it < 8; ++it) gpre[it] = *(const GAS u32x4*)(gp + (size_t)it * 4 * O.ldg); }
        if (u + G < nunits) PC_QLOAD(u + G);
#pragma unroll
        for (int r = 0; r < 16; ++r) { float a = 0.f, q2 = 0.f;
#pragma unroll
            for (int d = 0; d < 4; ++d) { a += o[d][r]; q2 += o[d][r] * o[d][r]; }
#pragma unroll
            for (int m = 1; m < 32; m <<= 1) { a += __shfl_xor(a, m); q2 += __shfl_xor(q2, m); }
            if (r32 == 0) red[wid * 32 + crow(r, hi)] = (f32x2){a, q2}; }
        __syncthreads();
        { float gv[4];
#pragma unroll
          for (int d = 0; d < 4; ++d) gv[d] = O.gain[dvh * 128 + 32 * d + r32];
#pragma unroll
          for (int r = 0; r < 16; ++r) { const int rw = crow(r, hi); const f32x2 pa_ = red[wid * 32 + rw], pb_ = red[(wid ^ 1) * 32 + rw];
              const float t1 = pa_.x + pb_.x, t2 = pa_.y + pb_.y; float mean, rstd;
              if (RET) { mean = t1 * (1.f / 256.f); rstd = rsqrtf(fmaxf(t2 * (1.f / 256.f) - mean * mean, 0.f) + EPS); } else { mean = 0.f; rstd = rsqrtf(t2 * (1.f / 256.f) + EPS); }
#pragma unroll
              for (int d = 0; d < 4; ++d) o[d][r] = (o[d][r] - mean) * rstd * gv[d]; } }
        LAS unsigned char* wb = lds + wid * 16384;
        otile_write(wb, o, r32, hi);
        asm volatile("s_waitcnt lgkmcnt(0)" ::: "memory");
        { int ln = lane; asm volatile("" : "+v"(ln));
          const int rr0 = ln >> 4, c8 = (ln & 15) * 8; const size_t row = row0 + 32 * qb + rr0;
          GAS bf16* mp = (GAS bf16*)O.mix + row * 2048 + h * 256 + dvh * 128 + c8; const LAS float* rp = (const LAS float*)wb + rr0 * 128 + c8;
#pragma unroll
          for (int it = 0; it < 8; ++it) { f32x4 a = *(const LAS f32x4*)(rp + it * 512), b2 = *(const LAS f32x4*)(rp + it * 512 + 4);
              const u32x4 g = gpre[it];
              a[0] *= silu_f(bflo(g.x)); a[1] *= silu_f(bfhi(g.x)); a[2] *= silu_f(bflo(g.y)); a[3] *= silu_f(bfhi(g.y)); b2[0] *= silu_f(bflo(g.z)); b2[1] *= silu_f(bfhi(g.z)); b2[2] *= silu_f(bflo(g.w)); b2[3] *= silu_f(bfhi(g.w));
              *(GAS u32x4*)(mp + (size_t)it * 4 * 2048) = pack8(a, b2); } }
    }
#undef PC_QLOAD
#undef PC_STATE
}
}

struct Args { const float* in[29]; float* out; unsigned char* ws; int ph_lo, ph_hi; };
struct Frame {
    LAS unsigned char* lds; volatile LAS unsigned* MISC; unsigned* ctl;
    int tid, lane, wave, vcu, G;
    const float* const* in; float* out; unsigned char* ws;
};
enum { I_X = 0, I_C, I_CTX, I_CCTX, I_ADAW, I_ADAB, I_NMIX, I_NFFN, I_NFIN, I_EVWIN, I_GLAW2, I_GLAB2, I_GLAN, I_MQN, I_WUQ, I_MKVN, I_WUKV, I_EVWOUT, I_FFNG, I_FFNU, I_FFND,
       I_ODWIN, I_RLD, I_RETN, I_ODWOUT, I_ROUTER, I_MOEG, I_MOEU, I_MOED };

struct MapId { int off; __device__ __forceinline__ int operator()(int n) const { return off + n; } };
struct MapGU { int up; __device__ __forceinline__ int operator()(int n) const { return (n >> 7) * 256 + up * 128 + (n & 127); } };
struct MapIn0 { __device__ __forceinline__ int operator()(int n) const {
    if (n < 3072) return n; if (n < 3088) return C_GAF + (n - 3072); if (n < 3104) return C_GAB + (n - 3088); if (n < 3872) return C_MQ + (n - 3104); if (n < 4384) return C_MKV + (n - 3872); return C_MKR + (n - 4384); } };
template <class RM> __device__ __forceinline__ void transpose_item(const float* W, int K, int N, bf16* WT, const RM& rm, LAS float* scr, int item, int lane) {
    const int nblk = N / 32, kb = item / nblk, nb = item % nblk, k0 = 64 * kb, n0 = 32 * nb;
#pragma unroll 8
    for (int i = 0; i < 32; ++i) { const int kk = 2 * i + (lane >> 5); scr[kk * 33 + (lane & 31)] = W[(size_t)(k0 + kk) * N + n0 + (lane & 31)]; }
    LDS_WAIT(); asm volatile("" ::: "memory");
    const int c = lane & 7;
#pragma unroll
    for (int j = 0; j < 4; ++j) { const int n = (lane >> 3) + 8 * j; const LAS float* s = scr + (8 * c) * 33 + n;
        u32x4 o; o.x = cvtpk(s[0 * 33], s[1 * 33]); o.y = cvtpk(s[2 * 33], s[3 * 33]); o.z = cvtpk(s[4 * 33], s[5 * 33]); o.w = cvtpk(s[6 * 33], s[7 * 33]);
        *(u32x4*)(WT + (size_t)rm(n0 + n) * K + k0 + 8 * c) = o; }
    LDS_WAIT(); asm volatile("" ::: "memory");
}
template <class RM> __device__ __forceinline__ void transpose_item8(const float* W, int K, int N, unsigned char* WT, const RM& rm, LAS float* scr, int item, int lane) {
    const int nblk = N / 32, kb = item / nblk, nb = item % nblk, k0 = 64 * kb, n0 = 32 * nb;
#pragma unroll 8
    for (int i = 0; i < 32; ++i) { const int kk = 2 * i + (lane >> 5); scr[kk * 33 + (lane & 31)] = W[(size_t)(k0 + kk) * N + n0 + (lane & 31)]; }
    LDS_WAIT(); asm volatile("" ::: "memory");
    const int c = lane & 7;
#pragma unroll
    for (int j = 0; j < 4; ++j) { const int n = (lane >> 3) + 8 * j; const LAS float* s = scr + (8 * c) * 33 + n;
        u32x2 o; o.x = pack4_fp8(s[0 * 33] * W8_SCALE, s[1 * 33] * W8_SCALE, s[2 * 33] * W8_SCALE, s[3 * 33] * W8_SCALE); o.y = pack4_fp8(s[4 * 33] * W8_SCALE, s[5 * 33] * W8_SCALE, s[6 * 33] * W8_SCALE, s[7 * 33] * W8_SCALE);
        *(u32x2*)(WT + (size_t)rm(n0 + n) * K + k0 + 8 * c) = o; }
    LDS_WAIT(); asm volatile("" ::: "memory");
}
__device__ __forceinline__ void sincos_acc(float af, float& s, float& c) {
    const double a = (double)af; const double n = rint(a * 0.63661977236758134308); const double r = (a - n * 1.57079632679489655800) - n * 6.12323399573676603587e-17;
    const double r2 = r * r;
    double sp = 1.0 / 6227020800.0; sp = sp * r2 - 1.0 / 39916800.0; sp = sp * r2 + 1.0 / 362880.0; sp = sp * r2 - 1.0 / 5040.0; sp = sp * r2 + 1.0 / 120.0; sp = sp * r2 - 1.0 / 6.0; sp = sp * r2 + 1.0; sp *= r;
    double cp = 1.0 / 479001600.0; cp = cp * r2 - 1.0 / 3628800.0; cp = cp * r2 + 1.0 / 40320.0; cp = cp * r2 - 1.0 / 720.0; cp = cp * r2 + 1.0 / 24.0; cp = cp * r2 - 0.5; cp = cp * r2 + 1.0;
    const int q = ((int)n) & 3; double ss, cc;
    if (q == 0) { ss = sp; cc = cp; } else if (q == 1) { ss = cp; cc = -sp; } else if (q == 2) { ss = -sp; cc = -cp; } else { ss = -cp; cc = sp; }
    s = (float)ss; c = (float)cc;
}

__device__ __forceinline__ void p_prologue(Frame& F) {
    LAS float* scr = (LAS float*)(F.lds + F.wave * 16384);
    const int gw = F.vcu * NWAVES + F.wave, NGW = F.G * NWAVES;
    unsigned char* ws = F.ws;
    constexpr int I0 = 32 * 139, I1 = 12 * 48, I2 = 8 * 64, I3 = 32 * 64, I4 = 32 * 176, I5 = I4, I6 = 88 * 64, I7 = 32 * 256, I8 = 32 * 64;
    constexpr int NITEMS = I0 + I1 + I2 + I3 + I4 + I5 + I6 + I7 + I8;
    for (int it = gw; it < NITEMS; it += NGW) {
        int r = it;
        if (r < I0) { transpose_item(F.in[I_EVWIN], 2048, 4448, (bf16*)(ws + WS_W_IN0), MapIn0{}, scr, r, F.lane); continue; } r -= I0;
        if (r < I1) { transpose_item(F.in[I_WUQ], 768, 1536, (bf16*)(ws + WS_W_UQ), MapId{0}, scr, r, F.lane); continue; } r -= I1;
        if (r < I2) { transpose_item(F.in[I_WUKV], 512, 2048, (bf16*)(ws + WS_W_UKV), MapId{0}, scr, r, F.lane); continue; } r -= I2;
        if (r < I3) { transpose_item(F.in[I_EVWOUT], 2048, 2048, (bf16*)(ws + WS_W_OUT0), MapId{0}, scr, r, F.lane); continue; } r -= I3;
        if (r < I4) { transpose_item(F.in[I_FFNG], 2048, 5632, (bf16*)(ws + WS_W_GU), MapGU{0}, scr, r, F.lane); continue; } r -= I4;
        if (r < I5) { transpose_item(F.in[I_FFNU], 2048, 5632, (bf16*)(ws + WS_W_GU), MapGU{1}, scr, r, F.lane); continue; } r -= I5;
        if (r < I6) { transpose_item8(F.in[I_FFND], 5632, 2048, ws + WS_W_DN, MapId{0}, scr, r, F.lane); continue; } r -= I6;
        if (r < I7) { transpose_item(F.in[I_ODWIN], 2048, 8192, (bf16*)(ws + WS_W_IN1), MapId{0}, scr, r, F.lane); continue; } r -= I7;
        transpose_item(F.in[I_ODWOUT], 2048, 2048, (bf16*)(ws + WS_W_OUT1), MapId{0}, scr, r, F.lane);
    }
    { u32x4* z = (u32x4*)((bf16*)(ws + WS_W_IN0) + (size_t)4448 * 2048); const int n16 = 160 * 2048 * 2 / 16;
      for (int i = F.vcu * NT + F.tid; i < n16; i += F.G * NT) z[i] = (u32x4){0u, 0u, 0u, 0u}; }
    { float* cm = (float*)(ws + WS_ROPE_M); float* cr = (float*)(ws + WS_ROPE_R);
      for (int i = F.vcu * NT + F.tid; i < ROPE_M_N + ROPE_R_N; i += F.G * NT) { const bool m = i < ROPE_M_N; const int half = m ? 16 : 64, j = m ? i : i - ROPE_M_N;
          const int pi = j / half, f = j % half; const float pos = (float)(pi < 256 ? pi : pi - 256);
          const float inv = 1.0f / powf(10000.0f, (float)(2 * f) / (float)(2 * half)); float sn, cs; sincos_acc(pos * inv, sn, cs);
          if (m) { cm[j] = cs; cm[ROPE_M_N + j] = sn; } else { cr[j] = cs; cr[ROPE_R_N + j] = sn; } } }
    __syncthreads();
    { LAS float* sc = (LAS float*)F.lds; LAS float* red = (LAS float*)(F.lds + 24576);
      for (int i = F.tid; i < 3 * 2048; i += NT) { const int s = i / 2048, k = i % 2048; const float v = (s < 2) ? F.in[I_C][s * 2048 + k] : F.in[I_CCTX][k]; sc[i] = silu_f(v); }
      __syncthreads();
      const int ks = F.tid >> 3, l8 = F.tid & 7;
      for (int it = F.vcu; it < 2 * 384; it += F.G) { const int l = it / 384, cg = it % 384; const int col = cg * 32 + 4 * l8;
          const GAS float* wp = (const GAS float*)F.in[I_ADAW] + (size_t)l * 2048 * 12288 + (size_t)(ks * 32) * 12288 + col;
          f32x4 a0 = {0.f, 0.f, 0.f, 0.f}, a1 = a0, a2 = a0;
#pragma unroll 16
          for (int k = 0; k < 32; ++k) { const f32x4 w = *(const GAS f32x4*)(wp + (size_t)k * 12288); const int kk = ks * 32 + k; a0 += w * sc[kk]; a1 += w * sc[2048 + kk]; a2 += w * sc[4096 + kk]; }
          LAS float* rp = red + (ks * 8 + l8) * 12;
          rp[0] = a0[0]; rp[1] = a0[1]; rp[2] = a0[2]; rp[3] = a0[3]; rp[4] = a1[0]; rp[5] = a1[1]; rp[6] = a1[2]; rp[7] = a1[3]; rp[8] = a2[0]; rp[9] = a2[1]; rp[10] = a2[2]; rp[11] = a2[3];
          __syncthreads();
          if (F.tid < 96) { const int s = F.tid / 32, c = F.tid % 32; float acc = 0.f;
              for (int q = 0; q < 64; ++q) acc += red[(q * 8 + (c >> 2)) * 12 + s * 4 + (c & 3)];
              const int n = cg * 32 + c; ((float*)(ws + WS_MOD))[((size_t)l * 3 + s) * 12288 + n] = acc + F.in[I_ADAB][l * 12288 + n]; }
          __syncthreads(); } }
}
struct MapSel { int gu, up; __device__ __forceinline__ int operator()(int n) const { return gu ? (n >> 7) * 256 + up * 128 + (n & 127) : n; } };
__device__ __forceinline__ void conv_round(Frame& F, int g) {
    LAS float* scr = (LAS float*)(F.lds + F.wave * 16384);
    const int kind = g >> 24, item = (g & 0xffffff) * 8 + F.wave;
    const float* W; unsigned char* WT; int K, N, r; MapSel rm;
    if (kind == 0) { const int e = item / (2 * 5632), q = item % (2 * 5632); const int up = q >= 5632 ? 1 : 0; r = q - up * 5632;
        W = F.in[up ? I_MOEU : I_MOEG] + (size_t)e * 2048 * 5632; WT = F.ws + WS_WMOE + (size_t)e * 11264 * 2048; K = 2048; N = 5632; rm = MapSel{1, up}; }
    else { const int e = item / 5632; r = item % 5632; W = F.in[I_MOED] + (size_t)e * 5632 * 2048; WT = F.ws + WS_WMOE_DN + (size_t)e * 2048 * 5632; K = 5632; N = 2048; rm = MapSel{0, 0}; }
    transpose_item8(W, K, N, WT, rm, scr, r, F.lane);
}
__device__ __forceinline__ int conv_grab(unsigned* ctl, unsigned x, bool allow_dn) {
    unsigned* q = ctl + CW_CQ + 64 * x;
    if (xb_ld(q) < (unsigned)CQ_GU_ROUNDS) { const unsigned r = xb_add(q, 1u); if (r < (unsigned)CQ_GU_ROUNDS) return (int)(x * CQ_GU_ROUNDS + r); }
    if (allow_dn) { unsigned* qd = q + 1024; if (xb_ld(qd) < (unsigned)CQ_DN_ROUNDS) { const unsigned r = xb_add(qd, 1u); if (r < (unsigned)CQ_DN_ROUNDS) return (1 << 24) | (int)(x * CQ_DN_ROUNDS + r); } }
    return -1;
}
__device__ __forceinline__ void xcd_barrier_fill(const XcdBarrier& b, Frame& F, bool allow_dn) {
    asm volatile("s_waitcnt vmcnt(0)" ::: "memory");
    __syncthreads();
    volatile LAS unsigned* st = b.st;
    if (threadIdx.x == 0) {
        unsigned* bar = b.bar;
        __builtin_amdgcn_s_waitcnt(0);
        unsigned nloc = st[0], nx = st[1];
        if (nloc == 0u) { xcd_barrier_complete(bar, b.x, nloc, nx); st[0] = nloc; st[1] = nx; }
        const unsigned old = xb_add(&bar[XB_XSUB(b.x)], 1u);
        const unsigned gen = old / nloc;
        if (old + 1u == (gen + 1u) * nloc) {
            __builtin_amdgcn_fence(__ATOMIC_RELEASE, "agent");
            asm volatile("s_waitcnt vmcnt(0)" ::: "memory");
            const unsigned og = xb_add(&bar[XB_TOP], 1u);
            const unsigned tg = og / nx;
            if (og + 1u == (tg + 1u) * nx) xb_add(&bar[XB_TOPGEN], 1u);
            else XB_SPIN_TIGHT(xb_ld(&bar[XB_TOPGEN]) == tg, bar);
            __builtin_amdgcn_fence(__ATOMIC_ACQUIRE, "agent");
            xb_add(&bar[XB_XGEN(b.x)], 1u);
            asm volatile("s_waitcnt vmcnt(0)" ::: "memory");
            st[2] = 0u;
        } else { st[2] = 1u; st[3] = gen; }
    }
    __syncthreads();
    if (st[2]) {
        for (;;) {
            if (threadIdx.x == 0) { unsigned* bar = b.bar; const unsigned gen = st[3]; int g = -2;
                if (xb_ld(&bar[XB_XGEN(b.x)]) == gen) { g = conv_grab(F.ctl, b.x & 7u, allow_dn);
                    if (g < 0) { XB_SPIN(xb_ld(&bar[XB_XGEN(b.x)]) == gen, bar); g = -2; } }
                st[4] = (unsigned)g; }
            __syncthreads();
            const int g = (int)st[4];
            if (g == -2) break;
            conv_round(F, g);
            __syncthreads();
        }
        if (threadIdx.x == 0) { __builtin_amdgcn_fence(__ATOMIC_ACQUIRE, "agent"); asm volatile("s_waitcnt vmcnt(0)" ::: "memory"); }
    }
    __syncthreads();
}
__device__ __forceinline__ void p_conv_drain(Frame& F, unsigned x) {
    volatile LAS unsigned* st = F.MISC + 16;
    __syncthreads();
    for (;;) {
        if (threadIdx.x == 0) { int g = -1;
            for (unsigned j = 0; j < 8u && g < 0; ++j) g = conv_grab(F.ctl, (x + j) & 7u, true);
            st[0] = (unsigned)g; }
        __syncthreads();
        const int g = (int)st[0];
        if (g < 0) break;
        conv_round(F, g);
        __syncthreads();
    }
}

template <bool ROUTER, bool OUT8 = false> __device__ __forceinline__ void p_norm(Frame& F, int layer, int ffn, int rmode, const float* srcLat, const float* srcCtx, int blk = -1, int nblk = 0) {
    const int gw = (blk >= 0 ? blk : F.vcu) * NWAVES + F.wave, NGW = (blk >= 0 ? nblk : F.G) * NWAVES;
    const int nrows = rmode == 1 ? MLAT : (rmode == 2 ? NB * CTX : MALL); const int rpw = (nrows + NGW - 1) / NGW;
    const float* gain = F.in[ffn ? I_NFFN : I_NMIX] + layer * 2048; const float* mod = (const float*)(F.ws + WS_MOD) + (size_t)layer * 3 * 12288;
    bf16* H = (bf16*)(F.ws + WS_H);
    LAS float* wr_l = (LAS float*)F.lds;
    if (ROUTER) { __syncthreads(); const float* wr = F.in[I_ROUTER];
        for (int i = F.tid; i < 2048 * 8; i += NT) { const int col = i >> 3, e = i & 7; wr_l[e * 2048 + col] = wr[i]; }
        __syncthreads(); }
    f32x4 A[8], Bv[8]; int curset = -1;
    const int r_lo = gw * rpw, r_hi = (r_lo + rpw < nrows) ? r_lo + rpw : nrows;
    auto rowsrc = [&](int r) -> const float* { int b, t; if (rmode == 1) { b = r / T; t = r % T; } else if (rmode == 2) { b = r / CTX; t = T + r % CTX; } else { b = r / SA; t = r % SA; }
        return (t >= T) ? srcCtx + ((size_t)b * CTX + (t - T)) * D : srcLat + ((size_t)b * T + t) * D; };
    f32x4 v[8];
    if (r_lo < r_hi) { const float* x0 = rowsrc(r_lo);
#pragma unroll
        for (int j = 0; j < 8; ++j) v[j] = *(const f32x4*)(x0 + 4 * F.lane + 256 * j); }
    for (int r = r_lo; r < r_hi; ++r) {
        int b, t; if (rmode == 1) { b = r / T; t = r % T; } else if (rmode == 2) { b = r / CTX; t = T + r % CTX; } else { b = r / SA; t = r % SA; }
        const bool isctx = t >= T; const int set = isctx ? 2 : b;
        f32x4 vn[8];
        { const float* xn = rowsrc((r + 1 < r_hi) ? r + 1 : r);
#pragma unroll
          for (int j = 0; j < 8; ++j) vn[j] = *(const f32x4*)(xn + 4 * F.lane + 256 * j); }
        if (set != curset) { curset = set; const float* sh = mod + (size_t)set * 12288 + (ffn ? 3 : 0) * 2048; const float* scv = sh + 2048;
#pragma unroll
            for (int j = 0; j < 8; ++j) { const int col = 4 * F.lane + 256 * j; const f32x4 g = *(const f32x4*)(gain + col), s = *(const f32x4*)(scv + col); A[j] = g * (s + 1.0f); Bv[j] = *(const f32x4*)(sh + col); } }
        float ss = 0.f;
#pragma unroll
        for (int j = 0; j < 8; ++j) ss += (v[j][0] * v[j][0] + v[j][1] * v[j][1]) + (v[j][2] * v[j][2] + v[j][3] * v[j][3]);
        const float rs = rsqrtf(wave_sum(ss) * (1.f / D) + EPS);
        const size_t urow = (size_t)b * SA + t;
        if constexpr (OUT8) { unsigned* o4 = (unsigned*)(F.ws + WS_H8 + urow * D) + F.lane;
#pragma unroll
            for (int j = 0; j < 8; ++j) { v[j] = v[j] * rs * A[j] + Bv[j]; o4[64 * j] = pack4_fp8(v[j][0], v[j][1], v[j][2], v[j][3]); }
        } else { u32x2* o8 = (u32x2*)(H + urow * D) + F.lane;
#pragma unroll
            for (int j = 0; j < 8; ++j) { v[j] = v[j] * rs * A[j] + Bv[j]; u32x2 w; w.x = cvtpk(v[j][0], v[j][1]); w.y = cvtpk(v[j][2], v[j][3]); o8[64 * j] = w; } }
        if (ROUTER) {
            float lg[8];
#pragma unroll
            for (int e = 0; e < 8; ++e) { float a = 0.f;
#pragma unroll
                for (int j = 0; j < 8; ++j) { const f32x4 w = *(const LAS f32x4*)(wr_l + e * 2048 + 4 * F.lane + 256 * j); a += (v[j][0] * w[0] + v[j][1] * w[1]) + (v[j][2] * w[2] + v[j][3] * w[3]); }
                lg[e] = wave_sum(a); }
            if (F.lane == 0) { int i0 = 0; float v0 = lg[0];
#pragma unroll
                for (int e = 1; e < 8; ++e) if (lg[e] > v0) { v0 = lg[e]; i0 = e; }
                int i1 = -1; float v1 = -3.0e38f;
#pragma unroll
                for (int e = 0; e < 8; ++e) if (e != i0 && lg[e] > v1) { v1 = lg[e]; i1 = e; }
                const float w1 = 1.f / (1.f + __expf(v0 - v1)), w0 = 1.f - w1;
                int* topi = (int*)(F.ws + WS_TOPI); float* topw = (float*)(F.ws + WS_TOPI + 262144); int* pos = (int*)(F.ws + WS_TOPI + 524288);
                topi[2 * r] = i0; topi[2 * r + 1] = i1; topw[2 * r] = w0; topw[2 * r + 1] = w1;
                pos[2 * r] = (int)__hip_atomic_fetch_add(F.ctl + CW_MOE + 64 * i0, 1u, RLX_AGENT); pos[2 * r + 1] = (int)__hip_atomic_fetch_add(F.ctl + CW_MOE + 64 * i1, 1u, RLX_AGENT); }
        }
#pragma unroll
        for (int j = 0; j < 8; ++j) v[j] = vn[j];
    }
}

__device__ __forceinline__ void p_prep0(Frame& F) {
    const int gw = F.vcu * NWAVES + F.wave, NGW = F.G * NWAVES;
    const bf16* P0 = (const bf16*)(F.ws + WS_P0);
    bf16* QL = (bf16*)(F.ws + WS_QLAT); bf16* KVL = (bf16*)(F.ws + WS_KVLAT); bf16* KR = (bf16*)(F.ws + WS_KR);
    const float* cm = (const float*)(F.ws + WS_ROPE_M); const float* sm = cm + ROPE_M_N;
    const float* qn = F.in[I_MQN]; const float* kvn = F.in[I_MKVN];
    float qg[12]; f32x4 kg0, kg1;
#pragma unroll
    for (int j = 0; j < 12; ++j) qg[j] = qn[12 * F.lane + j];
    kg0 = *(const f32x4*)(kvn + 8 * F.lane); kg1 = *(const f32x4*)(kvn + 8 * F.lane + 4);
    u32x2 na, nb2, nc2; u32x4 nkv; unsigned short nkr;
#define PREP_LOAD(r_) do { const GAS bf16* pr_ = (const GAS bf16*)P0 + (size_t)(r_) * N0; const GAS u32x2* p_ = (const GAS u32x2*)(pr_ + C_MQ + 12 * F.lane); na = p_[0]; nb2 = p_[1]; nc2 = p_[2]; \
        nkv = *(const GAS u32x4*)(pr_ + C_MKV + 8 * F.lane); nkr = pr_[C_MKR + F.lane]; } while (0)
    const int nex = (NB * NCH * 2) % F.G; const int gwm = (F.vcu - nex) * NWAVES + F.wave, NGWm = (F.G - nex) * NWAVES;
    if (F.vcu >= nex && gwm < MALL) PREP_LOAD(gwm);
    if (F.vcu >= nex) for (int r = gwm; r < MALL; r += NGWm) {
        const int t = r % SA;
        const u32x2 a = na, b2 = nb2, c2 = nc2; const u32x4 akv = nkv; const unsigned short akr = nkr;
        { const int rn = (r + NGWm < MALL) ? r + NGWm : r; PREP_LOAD(rn); }
        { float v[12] = {bflo(a.x), bfhi(a.x), bflo(a.y), bfhi(a.y), bflo(b2.x), bfhi(b2.x), bflo(b2.y), bfhi(b2.y), bflo(c2.x), bfhi(c2.x), bflo(c2.y), bfhi(c2.y)};
          float ss = 0.f;
#pragma unroll
          for (int j = 0; j < 12; ++j) ss += v[j] * v[j];
          const float rs = rsqrtf(wave_sum(ss) * (1.f / 768.f) + EPS);
          GAS u32x2* o = (GAS u32x2*)((GAS bf16*)QL + (size_t)r * 768 + 12 * F.lane);
#pragma unroll
          for (int j = 0; j < 3; ++j) { u32x2 w; w.x = cvtpk(v[4 * j] * rs * qg[4 * j], v[4 * j + 1] * rs * qg[4 * j + 1]); w.y = cvtpk(v[4 * j + 2] * rs * qg[4 * j + 2], v[4 * j + 3] * rs * qg[4 * j + 3]); o[j] = w; } }
        { const u32x4 a4 = akv; float v[8] = {bflo(a4.x), bfhi(a4.x), bflo(a4.y), bfhi(a4.y), bflo(a4.z), bfhi(a4.z), bflo(a4.w), bfhi(a4.w)};
          float ss = 0.f;
#pragma unroll
          for (int j = 0; j < 8; ++j) ss += v[j] * v[j];
          const float rs = rsqrtf(wave_sum(ss) * (1.f / 512.f) + EPS);
          u32x4 w; w.x = cvtpk(v[0] * rs * kg0[0], v[1] * rs * kg0[1]); w.y = cvtpk(v[2] * rs * kg0[2], v[3] * rs * kg0[3]); w.z = cvtpk(v[4] * rs * kg1[0], v[5] * rs * kg1[1]); w.w = cvtpk(v[6] * rs * kg1[2], v[7] * rs * kg1[3]);
          *(GAS u32x4*)((GAS bf16*)KVL + (size_t)r * 512 + 8 * F.lane) = w; }
        { float x = bf2f(akr); const float xo = __shfl_xor(x, 1);
          if (t < T) { const int ri = F.lane >> 1, ro = ((ri & 16) ? 256 + (t & 63) : (t >> 6)) * 16 + (ri & 15); const float c = ((const GAS float*)cm)[ro], s = ((const GAS float*)sm)[ro]; x = (F.lane & 1) ? (xo * s + x * c) : (x * c - xo * s); }
          ((GAS bf16*)KR)[(size_t)r * 64 + F.lane] = f2bf(x); }
    }
#undef PREP_LOAD
    __syncthreads();
    { LAS unsigned char* lds = F.lds; LAS float* ga = (LAS float*)lds;
      constexpr int INB = 16384, OUTB = 49152;
      const int dir0 = __builtin_amdgcn_readfirstlane(F.tid >> 8); const float* w2 = F.in[I_GLAW2]; const float* b2 = F.in[I_GLAB2];
      const int wid = F.wave;
      float* GE = (float*)(F.ws + WS_GE);
      const float qs = 0.08838834764831845f;
      for (int u = F.vcu; u < NB * NCH * 2; u += F.G) { const int half = u & 1, bc = u >> 1, b = bc / NCH, cid = bc % NCH; const size_t row0 = (size_t)b * SA + (size_t)cid * 128;
          int chl = F.tid & 255; asm volatile("" : "+v"(chl));
          int dir = dir0; asm volatile("" : "+s"(dir));
          const int ch = chl + 256 * half;
          float wv[16];
#pragma unroll
          for (int q = 0; q < 16; ++q) wv[q] = w2[dir * 16 * 512 + q * 512 + ch];
          const float bias = b2[dir * 512 + ch];
          const int pqk = (F.tid >> 8) & 1, ptk = (F.tid >> 5) & 7, pc8 = (F.tid & 31) * 8;
          const GAS bf16* src0 = (const GAS bf16*)P0 + (row0 + ptk) * N0 + (pqk ? C_GK : C_GQ) + half * 256 + pc8;
#define GLA_TB(d_, it_) ((d_) ? 120 - 8 * (it_) : 8 * (it_))
#define GLA_DMA(it_) do { _Pragma("unroll") for (int i_ = 0; i_ < 2; ++i_) __builtin_amdgcn_global_load_lds((const unsigned*)(src0 + (size_t)GLA_TB(i_, it_) * N0), \
              (LAS unsigned*)(lds + INB + ((it_) & 1) * 16384 + (i_ * 512 + wid * 64) * 16), 16, 0, 0); } while (0)
#define GLA_FLUSH(it_) do { _Pragma("unroll") for (int i_ = 0; i_ < 2; ++i_) { const u32x4 o_ = *(const LAS u32x4*)(lds + OUTB + ((it_) & 1) * 16384 + (i_ * 512 + F.tid) * 16); \
              *(GAS u32x4*)((GAS bf16*)(F.ws + WS_GQK + (size_t)(2 * i_ + pqk) * GQK_STRIDE) + (row0 + GLA_TB(i_, it_) + ptk) * 512 + half * 256 + pc8) = o_; } } while (0)
          for (int i = F.tid; i < 128 * 32; i += NT) { const int tt = i >> 5, q = i & 31; ga[i] = bf2f(((const GAS bf16*)P0)[(row0 + tt) * N0 + C_GAF + q]); }
          GLA_DMA(0);
          asm volatile("s_waitcnt vmcnt(0) lgkmcnt(0)" ::: "memory"); __builtin_amdgcn_s_barrier();
          float Bc = 0.f;
#pragma unroll 1
          for (int it = 0; it < 16; ++it) {
              if (it + 1 < 16) GLA_DMA(it + 1);
              if (it > 0) GLA_FLUSH(it - 1);
              const LAS unsigned short* inq = (const LAS unsigned short*)(lds + INB + (it & 1) * 16384 + dir * 8192) + chl; LAS unsigned short* outq = (LAS unsigned short*)(lds + OUTB + (it & 1) * 16384 + dir * 8192) + chl;
#pragma unroll
              for (int j = 0; j < 8; ++j) { const int tk = dir ? 7 - j : j; const int tt = GLA_TB(dir, it) + tk;
                  const LAS f32x4* g = (const LAS f32x4*)(ga + tt * 32 + 16 * dir); float x = bias;
#pragma unroll
                  for (int q = 0; q < 4; ++q) { const f32x4 gq = g[q]; x += gq[0] * wv[4 * q] + gq[1] * wv[4 * q + 1] + gq[2] * wv[4 * q + 2] + gq[3] * wv[4 * q + 3]; }
                  const float xl = x * 1.4426950408889634f; const float l2 = fminf(xl, 0.f) - __builtin_amdgcn_logf(1.f + __builtin_amdgcn_exp2f(-fabsf(xl)));
                  Bc += l2 * (1.f / 16.f); const float e = __builtin_amdgcn_exp2f(Bc), ei = __builtin_amdgcn_exp2f(-Bc);
                  const float qv = bf2f(inq[tk * 256]), kv = bf2f(inq[2048 + tk * 256]);
                  outq[tk * 256] = f2bf(qv * qs * e); outq[2048 + tk * 256] = f2bf(kv * ei); }
              if (it > 0) asm volatile("s_waitcnt vmcnt(2)" ::: "memory"); else asm volatile("s_waitcnt vmcnt(0)" ::: "memory");
              asm volatile("s_waitcnt lgkmcnt(0)" ::: "memory"); __builtin_amdgcn_s_barrier();
          }
          GLA_FLUSH(15);
#undef GLA_TB
#undef GLA_DMA
#undef GLA_FLUSH
          GE[((size_t)(dir * 2 + b) * NCH + cid) * 512 + ch] = __builtin_amdgcn_exp2f(Bc);
          __syncthreads(); } }
}

__device__ __forceinline__ void moe_bases(const Frame& F, int* base  ) {
    int acc = 0;
#pragma unroll
    for (int e = 0; e < NEXP; ++e) { base[e] = acc; const int c = __builtin_amdgcn_readfirstlane((int)__hip_atomic_load(F.ctl + CW_MOE + 64 * e, RLX_AGENT)); acc += (c + 255) & ~255; }
    base[NEXP] = acc;
}
__device__ __forceinline__ void p_moe_gather(Frame& F) {
    const int gw = F.vcu * NWAVES + F.wave, NGW = F.G * NWAVES;
    int base[NEXP + 1]; moe_bases(F, base);
    const GAS int* topi = (const GAS int*)(F.ws + WS_TOPI); GAS int* pos = (GAS int*)(F.ws + WS_TOPI + 524288);
    const GAS unsigned char* H8 = (const GAS unsigned char*)(F.ws + WS_H8); GAS unsigned char* HG = (GAS unsigned char*)(F.ws + WS_HG);
    const int nmine = (MLAT - gw + NGW - 1) / NGW;
    for (int k0 = 0; k0 < nmine; k0 += 64) {
        int d0v = 0, d1v = 0;
        if (k0 + F.lane < nmine) { const int lr = gw + (k0 + F.lane) * NGW; const int e0 = topi[2 * lr], e1 = topi[2 * lr + 1]; int b0 = 0, b1 = 0;
#pragma unroll
            for (int j = 0; j < NEXP; ++j) { b0 = (e0 == j) ? base[j] : b0; b1 = (e1 == j) ? base[j] : b1; }
            d0v = b0 + pos[2 * lr]; d1v = b1 + pos[2 * lr + 1];
            pos[2 * lr] = d0v; pos[2 * lr + 1] = d1v; }
        const int kn = (nmine - k0 < 64) ? nmine - k0 : 64;
        for (int kb = 0; kb < kn; kb += 8) {
            u32x4 a0[8], a1[8];
#pragma unroll
            for (int q = 0; q < 8; ++q) if (kb + q < kn) { const int lr = gw + (k0 + kb + q) * NGW; const int b = lr / T, t = lr % T;
                const GAS u32x4* src = (const GAS u32x4*)(H8 + ((size_t)b * SA + t) * D); a0[q] = src[F.lane]; a1[q] = src[64 + F.lane]; }
#pragma unroll
            for (int q = 0; q < 8; ++q) if (kb + q < kn) { const int dA = __builtin_amdgcn_readlane(d0v, kb + q), dB = __builtin_amdgcn_readlane(d1v, kb + q);
                GAS u32x4* da = (GAS u32x4*)(HG + (size_t)dA * D); GAS u32x4* db = (GAS u32x4*)(HG + (size_t)dB * D);
                da[F.lane] = a0[q]; da[64 + F.lane] = a1[q]; db[F.lane] = a0[q]; db[64 + F.lane] = a1[q]; } } }
}
__device__ __forceinline__ void p_final(Frame& F, float* dst_override = nullptr) {
    const int gw = F.vcu * NWAVES + F.wave, NGW = F.G * NWAVES;
    const GAS float* topw = (const GAS float*)(F.ws + WS_TOPI + 262144); const GAS int* pos = (const GAS int*)(F.ws + WS_TOPI + 524288);
    const GAS bf16* Y = (const GAS bf16*)(F.ws + WS_Y); const GAS float* gfin = (const GAS float*)F.in[I_NFIN];
    const GAS float* mod1 = (const GAS float*)(F.ws + WS_MOD) + (size_t)3 * 12288;
    const GAS float* xin = (const GAS float*)F.out; GAS float* xout = (GAS float*)(dst_override ? dst_override : F.out);
    const int nmine = (MLAT - gw + NGW - 1) / NGW;
    const int c0 = 8 * F.lane;
    f32x4 gn[8];
#pragma unroll
    for (int j = 0; j < 4; ++j) { gn[2 * j] = *(const GAS f32x4*)(gfin + c0 + 512 * j); gn[2 * j + 1] = *(const GAS f32x4*)(gfin + c0 + 512 * j + 4); }
    f32x4 gg[8]; int curb = -1;
    for (int k0 = 0; k0 < nmine; k0 += 64) {
        int mp0 = 0, mp1 = 0; float mw0 = 0.f, mw1 = 0.f;
        { const int lrm = gw + (k0 + F.lane) * NGW; if (k0 + F.lane < nmine) { mp0 = pos[2 * lrm]; mp1 = pos[2 * lrm + 1]; mw0 = topw[2 * lrm]; mw1 = topw[2 * lrm + 1]; } }
        const int kn = (nmine - k0 < 64) ? nmine - k0 : 64;
        f32x4 x[8]; u32x4 ya[4], yc[4];
#define FIN_LOAD(X_, A_, C_, kk_) do { const GAS float* xr_ = xin + (size_t)(gw + (k0 + (kk_)) * NGW) * D + c0; \
          const GAS bf16* y0_ = Y + (size_t)__builtin_amdgcn_readlane(mp0, (kk_)) * D + c0; const GAS bf16* y1_ = Y + (size_t)__builtin_amdgcn_readlane(mp1, (kk_)) * D + c0; \
          _Pragma("unroll") for (int j = 0; j < 4; ++j) { X_[2 * j] = *(const GAS f32x4*)(xr_ + 512 * j); X_[2 * j + 1] = *(const GAS f32x4*)(xr_ + 512 * j + 4); A_[j] = *(const GAS u32x4*)(y0_ + 512 * j); C_[j] = *(const GAS u32x4*)(y1_ + 512 * j); } } while (0)
        FIN_LOAD(x, ya, yc, 0);
        for (int k = 0; k < kn; ++k) { const int lr = gw + (k0 + k) * NGW; const int b = lr / T;
            if (b != curb) { curb = b; const GAS float* gf = mod1 + (size_t)b * 12288 + 5 * 2048 + c0;
#pragma unroll
                for (int j = 0; j < 4; ++j) { gg[2 * j] = *(const GAS f32x4*)(gf + 512 * j); gg[2 * j + 1] = *(const GAS f32x4*)(gf + 512 * j + 4); } }
            const float w0 = __builtin_bit_cast(float, __builtin_amdgcn_readlane(__builtin_bit_cast(int, mw0), k)), w1 = __builtin_bit_cast(float, __builtin_amdgcn_readlane(__builtin_bit_cast(int, mw1), k));
            f32x4 xn[8]; u32x4 yan[4], ycn[4];
            { const int k1 = (k + 1 < kn) ? k + 1 : k; FIN_LOAD(xn, yan, ycn, k1); }
            f32x4 v[8]; float ss = 0.f;
#pragma unroll
            for (int j = 0; j < 4; ++j) { const u32x4 a = ya[j], c = yc[j];
                f32x4 y0v, y1v; y0v[0] = w0 * bflo(a.x) + w1 * bflo(c.x); y0v[1] = w0 * bfhi(a.x) + w1 * bfhi(c.x); y0v[2] = w0 * bflo(a.y) + w1 * bflo(c.y); y0v[3] = w0 * bfhi(a.y) + w1 * bfhi(c.y);
                y1v[0] = w0 * bflo(a.z) + w1 * bflo(c.z); y1v[1] = w0 * bfhi(a.z) + w1 * bfhi(c.z); y1v[2] = w0 * bflo(a.w) + w1 * bflo(c.w); y1v[3] = w0 * bfhi(a.w) + w1 * bfhi(c.w);
                v[2 * j] = x[2 * j] + gg[2 * j] * y0v; v[2 * j + 1] = x[2 * j + 1] + gg[2 * j + 1] * y1v; }
#pragma unroll
            for (int j = 0; j < 8; ++j) ss += (v[j][0] * v[j][0] + v[j][1] * v[j][1]) + (v[j][2] * v[j][2] + v[j][3] * v[j][3]);
            const float rs = rsqrtf(wave_sum(ss) * (1.f / D) + EPS);
            GAS float* xw = xout + (size_t)lr * D + c0;
#pragma unroll
            for (int j = 0; j < 4; ++j) { *(GAS f32x4*)(xw + 512 * j) = v[2 * j] * rs * gn[2 * j]; *(GAS f32x4*)(xw + 512 * j + 4) = v[2 * j + 1] * rs * gn[2 * j + 1]; }
#pragma unroll
            for (int j = 0; j < 8; ++j) x[j] = xn[j];
#pragma unroll
            for (int j = 0; j < 4; ++j) { ya[j] = yan[j]; yc[j] = ycn[j]; } }
#undef FIN_LOAD
    }
}

__device__ __forceinline__ void sub_barrier(Frame& F, unsigned n_total) {
    asm volatile("s_waitcnt vmcnt(0)" ::: "memory");
    __syncthreads();
    if (threadIdx.x == 0) { unsigned* ctr = F.ctl + CW_SUB; unsigned* bar = F.ctl + CW_BAR;
        __builtin_amdgcn_fence(__ATOMIC_RELEASE, "agent");
        asm volatile("s_waitcnt vmcnt(0)" ::: "memory");
        (void)xb_add(ctr, 1u);
        XB_SPIN(xb_ld(ctr) < n_total, bar);
        __builtin_amdgcn_fence(__ATOMIC_ACQUIRE, "agent");
        asm volatile("s_waitcnt vmcnt(0)" ::: "memory"); }
    __syncthreads();
}
#define ONE_LAUNCH 1
#define DUPX 0
constexpr int NPHASE = 23;
#ifndef STOP_AFTER
#define STOP_AFTER 22
#endif
#ifndef PROBE_KIND
#define PROBE_KIND 0
#endif
#ifndef PROBE_OFF
#define PROBE_OFF 0
#endif
__global__ void __launch_bounds__(NT, 2) fwd_kernel(Args args) {
    extern __shared__ __attribute__((aligned(16))) unsigned char lds_raw[];
    Frame F;
    F.lds = (LAS unsigned char*)lds_raw; F.MISC = (volatile LAS unsigned*)(F.lds + MISC_OFF);
    F.tid = threadIdx.x; F.lane = F.tid & 63; F.wave = __builtin_amdgcn_readfirstlane(F.tid >> 6);
    F.G = gridDim.x; { const int bx = blockIdx.x; F.vcu = (F.G % 8 == 0) ? (bx % 8) * (F.G / 8) + bx / 8 : bx; }
    F.in = args.in; F.out = args.out; F.ws = args.ws; F.ctl = (unsigned*)(args.ws + WS_CTL);
    for (int u = F.tid; u < (LDS_BYTES - MISC_OFF) / 4; u += NT) ((LAS unsigned*)(F.lds + MISC_OFF))[u] = 0u;
    __syncthreads();
    const int lo = args.ph_lo, hi = args.ph_hi;
    XcdBarrier bar; bar.bar = F.ctl + CW_BAR; bar.x = 0; bar.st = nullptr;
    if (hi - lo > 1) bar = xcd_barrier_post(F.ctl + CW_BAR, F.MISC + 8);
#ifdef ONLY_PHASE
#define IN(k) ((k) == ONLY_PHASE && lo <= (k) && (k) < hi)
#else
#define IN(k) (lo <= (k) && (k) < hi)
#endif
#define SEAM(k) do { if (IN(k) && IN((k) + 1)) xcd_barrier_fill(bar, F, (k) >= 12); } while (0)
    const int cidx = (int)blockIdx.x;
#define PHASE_WS() unsigned char* ws = args.ws; asm volatile("" : "+s"(ws)); F.ws = ws; F.ctl = (unsigned*)(ws + WS_CTL); float* XC = (float*)(ws + WS_XC); bf16* H = (bf16*)(ws + WS_H); const float* mod0 = (const float*)(ws + WS_MOD); const float* mod1 = mod0 + 3 * 12288; (void)XC; (void)H; (void)mod0; (void)mod1
#define GLA_SRC(S) scan::Src S; S.q0 = (const bf16*)(ws + WS_GQK); S.k0 = (const bf16*)(ws + WS_GQK + GQK_STRIDE); S.q1 = (const bf16*)(ws + WS_GQK + 2 * GQK_STRIDE); S.k1 = (const bf16*)(ws + WS_GQK + 3 * GQK_STRIDE); \
        S.v = (const bf16*)(ws + WS_P0) + C_GV; S.ldq = 512; S.ldk = 512; S.ldv = N0; S.hsq = 128; S.hsv = 256; S.H = 4; S.ws = (bf16*)(ws + WS_GWS); S.egla = (const float*)(ws + WS_GE); S.rld = nullptr
#define RET_SRC(S) scan::Src S; { const bf16* P1 = (const bf16*)(ws + WS_P1); S.q0 = P1; S.k0 = P1 + 8 * P1PLANE; S.q1 = P1; S.k1 = P1 + 16 * P1PLANE; S.v = P1 + 24 * P1PLANE; S.ldq = S.ldk = S.ldv = 256; S.hsq = S.hsv = P1PLANE; S.H = 8; S.ws = (bf16*)(ws + WS_RWS); S.egla = nullptr; S.rld = F.in[I_RLD]; }

    if (IN(0)) { PHASE_WS(); p_prologue(F);
#if DUPX == 2 || DUPX == 7
        __syncthreads(); p_prologue(F);
#endif
#ifdef PROBE_PRO
        _Pragma("nounroll") for (int rep = 0; rep < 3; ++rep) { __syncthreads(); p_prologue(F); }
#endif
        } SEAM(0);
    if (IN(1)) { PHASE_WS(); p_norm<false>(F, 0, 0, false, F.in[I_X], F.in[I_CTX]);
#if DUPX == 2 || DUPX == 6
        p_norm<false>(F, 0, 0, false, F.in[I_X], F.in[I_CTX]);
#endif
        } SEAM(1);
    if (IN(2)) { PHASE_WS(); pg8::DenseOrder S; S.init(MALL / 256, N0 / 256, F.G, cidx, H, D * 2, ws + WS_W_IN0, D * 2, 0);
        EpiStoreBf16 E{(bf16*)(ws + WS_P0), N0}; pg8::gemm_phase(F.lds, D * 2, D * 2, D * 2, S, E); } SEAM(2);
    if (IN(3)) { PHASE_WS(); p_prep0(F);
#if DUPX == 2 || DUPX == 8
        __syncthreads(); p_prep0(F);
#endif
#ifdef PROBE_PREP0
        _Pragma("nounroll") for (int rep = 0; rep < 3; ++rep) { __syncthreads(); p_prep0(F); }
#endif
        } SEAM(3);
    if (IN(4)) { PHASE_WS();
        { pg8::DenseOrder S; S.init(MALL / 256, 1536 / 256, F.G, cidx, ws + WS_QLAT, 768 * 2, ws + WS_W_UQ, 768 * 2, 0);
          EpiQRope E{(bf16*)(ws + WS_Q), (const float*)(ws + WS_ROPE_M), (const float*)(ws + WS_ROPE_M) + ROPE_M_N, 0.07216878364870322f * 1.4426950408889634f};
#ifdef PROBE_P4Q
          _Pragma("nounroll") for (int rep = 0; rep < 3; ++rep) { pg8::gemm_phase(F.lds, 768 * 2, 768 * 2, 768 * 2, S, E); __syncthreads(); }
#endif
          pg8::gemm_phase(F.lds, 768 * 2, 768 * 2, 768 * 2, S, E); }
        { pg8::DenseOrder S; S.init(MALL / 256, 2048 / 256, F.G, (cidx + F.G - 12) % F.G, ws + WS_KVLAT, 512 * 2, ws + WS_W_UKV, 512 * 2, 0);
          EpiStoreBf16 E{(bf16*)(ws + WS_KV), 2048}; pg8::gemm_phase(F.lds, 512 * 2, 512 * 2, 512 * 2, S, E); }
#ifdef PROBE_P4A
        _Pragma("nounroll") for (int rep = 0; rep < 3; ++rep) { GLA_SRC(S); scan::phaseA<128>(S, F.lds, F.G, F.vcu); __syncthreads(); }
#endif
        { GLA_SRC(S); scan::phaseA<128>(S, F.lds, F.G, (F.vcu + F.G - 28) % F.G);
#if DUPX == 3
          scan::phaseA<128>(S, F.lds, F.G, F.vcu);
#endif
        }
    } SEAM(4);
#ifndef GLAB_PF
#define GLAB_PF 8
#endif
    if (IN(5)) { PHASE_WS(); GLA_SRC(S);
#ifdef PROBE_GB
        _Pragma("nounroll") for (int rep = 0; rep < 3; ++rep) { scan::phaseB<128, false, GLAB_PF>(S, F.G, F.vcu, (size_t)262 * 1024 * 1024 / 2); __syncthreads(); }
#endif
        scan::phaseB<128, false, GLAB_PF>(S, F.G, F.vcu); } SEAM(5);
    if (IN(6)) { PHASE_WS();
#ifndef NO_GLAC
        { GLA_SRC(S); scan::OutC O{(const bf16*)(ws + WS_P0) + C_GR, N0, F.in[I_GLAN], (bf16*)(ws + WS_MIX0), 256};
#ifdef PROBE_GC
          _Pragma("nounroll") for (int rep = 0; rep < 3; ++rep) { scan::phaseC<128, false>(S, O, NCH, F.lds, F.G, F.vcu); __syncthreads(); }
#endif
          scan::phaseC<128, false>(S, O, NCH, F.lds, F.G, F.vcu);
#if DUPX == 3
          scan::phaseC<128, false>(S, O, NCH, F.lds, F.G, F.vcu);
#endif
        }
#endif
        { const bf16* Q = (const bf16*)(ws + WS_Q); const bf16* KV = (const bf16*)(ws + WS_KV); const bf16* KR = (const bf16*)(ws + WS_KR); bf16* MIX = (bf16*)(ws + WS_MIX0);
#ifdef DUPATT
          for (int rep = 0; rep < 2; ++rep)
#endif
          for (int u = F.vcu; u < 16 * 65; u += F.G) { int bh, qb; if (u < 1024) { bh = u >> 6; qb = u & 63; } else { bh = u - 1024; qb = 64; }
              const int b = bh >> 3, h = bh & 7; const size_t qrow = (size_t)b * SA + (size_t)qb * 256; const size_t krow = (size_t)b * SA + (qb == 64 ? T : 0); const int nkeys = (qb == 64) ? CTX : SA;
              mla::attn_unit(Q + qrow * 1536 + h * 192, KV + krow * 2048 + h * 256, KV + krow * 2048 + h * 256 + 128, KR + krow * 64, MIX + qrow * 2048 + 1024 + h * 128, nkeys, F.lds); }
          __syncthreads(); }
    } SEAM(6);
    const bool side_ok = F.G > 32;
    if (IN(7)) { PHASE_WS(); pg8::DenseOrder S; S.init(side_ok ? MLAT / 256 : MALL / 256, D / 256, F.G, cidx, ws + WS_MIX0, D * 2, ws + WS_W_OUT0, D * 2, side_ok ? 1 : 0);
        EpiResid E{F.in[I_X], F.in[I_CTX], F.out, XC, mod0 + 2 * 2048}; pg8::gemm_phase(F.lds, D * 2, D * 2, D * 2, S, E); } SEAM(7);
    if (IN(8) && side_ok) { PHASE_WS();
        if (cidx < 16) { pg8::CtxOrder S; S.init(D / 256, F.G, cidx, ws + WS_MIX0, D * 2, ws + WS_W_OUT0, D * 2);
            EpiResid E{F.in[I_X], F.in[I_CTX], F.out, XC, mod0 + 2 * 2048}; pg8::gemm_phase(F.lds, D * 2, D * 2, D * 2, S, E);
            sub_barrier(F, 16u); p_norm<false>(F, 0, 1, 2, F.out, XC, cidx, 16); }
        else p_norm<false>(F, 0, 1, 1, F.out, XC, cidx - 16, F.G - 16);
    } else if (IN(8)) { PHASE_WS(); p_norm<false>(F, 0, 1, false, F.out, XC);
#if DUPX == 2 || DUPX == 6
        p_norm<false>(F, 0, 1, false, F.out, XC);
#endif
        } SEAM(8);
    if (IN(9)) { PHASE_WS(); pg8::DenseOrder S; S.init(MALL / 256, 2 * DFF / 256, F.G, cidx, H, D * 2, ws + WS_W_GU, D * 2, 0);
        EpiSwiGLUto8 E{ws + WS_HID, DFF}; pg8::gemm_phase(F.lds, D * 2, D * 2, D * 2, S, E); } SEAM(9);
    if (IN(10)) { PHASE_WS(); pg8::DenseOrder S; S.init(side_ok ? MLAT / 256 : MALL / 256, D / 256, F.G, cidx, ws + WS_HID, DFF, ws + WS_W_DN, DFF, side_ok ? 1 : 0);
        EpiResid E{F.out, XC, F.out, XC, mod0 + 5 * 2048, 1.f / (W8_SCALE * H8_SCALE)}; pg8::gemm_phase<EpiResid, pg8::DenseOrder, true>(F.lds, DFF, DFF, DFF, S, E); } SEAM(10);
    if (IN(11) && side_ok) { PHASE_WS();
        if (cidx < 16) { pg8::CtxOrder S; S.init(D / 256, F.G, cidx, ws + WS_HID, DFF, ws + WS_W_DN, DFF);
            EpiResid E{F.out, XC, F.out, XC, mod0 + 5 * 2048, 1.f / (W8_SCALE * H8_SCALE)}; pg8::gemm_phase<EpiResid, pg8::CtxOrder, true>(F.lds, DFF, DFF, DFF, S, E);
            sub_barrier(F, 32u); p_norm<false>(F, 1, 0, 2, F.out, XC, cidx, 16); }
        else p_norm<false>(F, 1, 0, 1, F.out, XC, cidx - 16, F.G - 16);
    } else if (IN(11)) { PHASE_WS(); p_norm<false>(F, 1, 0, false, F.out, XC);
#if DUPX == 2 || DUPX == 6
        p_norm<false>(F, 1, 0, false, F.out, XC);
#endif
        } SEAM(11);
    if (IN(12)) { PHASE_WS(); pg8::DenseOrder S; S.init(MALL / 256, N1 / 256, F.G, cidx, H, D * 2, ws + WS_W_IN1, D * 2, 0);
        EpiIn1 E{(bf16*)(ws + WS_P1), (const float*)(ws + WS_ROPE_R), (const float*)(ws + WS_ROPE_R) + ROPE_R_N, F.in[I_RLD]}; pg8::gemm_phase(F.lds, D * 2, D * 2, D * 2, S, E); } SEAM(12);
    if (IN(13)) { PHASE_WS(); RET_SRC(RS);
#ifdef ABPROBE
        for (int rep = 0; rep < 3; ++rep) { scan::phaseAB<256, ABPROBE>(RS, F.lds, F.G, F.vcu); __syncthreads(); }
#endif
        scan::phaseAB<256>(RS, F.lds, F.G, F.vcu); }
    if (IN(13) && IN(15)) xcd_barrier_fill(bar, F, true);
    if (IN(15)) { PHASE_WS(); RET_SRC(RS); scan::OutC O{(const bf16*)(ws + WS_P1) + 32 * P1PLANE, 256, F.in[I_RETN], (bf16*)(ws + WS_MIX1), P1PLANE};
#ifdef PROBE_C
        _Pragma("nounroll") for (int rep = 0; rep < 3; ++rep) { scan::phaseC<256, true, PROBE_C & 15>(RS, O, 128, F.lds, F.G, F.vcu); __syncthreads(); }
#endif
        scan::phaseC<256, true>(RS, O, 128, F.lds, F.G, F.vcu);
#if DUPX == 3 || DUPX == 5
        scan::phaseC<256, true>(RS, O, 128, F.lds, F.G, F.vcu);
#endif
        } SEAM(15);
    if (IN(16)) { PHASE_WS(); pg8::DenseOrder S; S.init(MLAT / 256, D / 256, F.G, cidx, ws + WS_MIX1, D * 2, ws + WS_W_OUT1, D * 2, 1);
        EpiResid E{F.out, XC, F.out, XC, mod1 + 2 * 2048}; pg8::gemm_phase(F.lds, D * 2, D * 2, D * 2, S, E); } SEAM(16);
    if (IN(17)) { PHASE_WS(); p_norm<true, true>(F, 1, 1, true, F.out, XC); } SEAM(17);
    if (IN(18)) { PHASE_WS(); p_moe_gather(F); p_conv_drain(F, bar.x); } SEAM(18);
    if (IN(19)) { PHASE_WS(); pg8::GroupedOrder S; int base[NEXP + 1]; moe_bases(F, base);
#pragma unroll
        for (int e = 0; e <= NEXP; ++e) S.ts[e] = base[e] >> 8;
        S.nM = S.ts[NEXP]; S.nN = 2 * DFF / 256; S.nwg = S.nM * S.nN; S.G = F.G; S.c = cidx; S.A = (const char*)(ws + WS_HG); S.Bt = (const char*)(ws + WS_WMOE); S.tstepA = (size_t)256 * D; S.tstepB = (size_t)256 * D; S.estride = (size_t)2 * DFF * D;
        EpiSwiGLU8 E{ws + WS_HIDM, DFF}; pg8::gemm_phase<EpiSwiGLU8, pg8::GroupedOrder, true>(F.lds, D, D, D, S, E); } SEAM(19);
    if (IN(21)) { PHASE_WS(); pg8::GroupedOrder S; int base[NEXP + 1]; moe_bases(F, base);
#pragma unroll
        for (int e = 0; e <= NEXP; ++e) S.ts[e] = base[e] >> 8;
        S.nM = S.ts[NEXP]; S.nN = D / 256; S.nwg = S.nM * S.nN; S.G = F.G; S.c = cidx; S.A = (const char*)(ws + WS_HIDM); S.Bt = (const char*)(ws + WS_WMOE_DN); S.tstepA = (size_t)256 * DFF; S.tstepB = (size_t)256 * DFF; S.estride = (size_t)D * DFF;
        EpiStoreBf16 E{(bf16*)(ws + WS_Y), D, 1.f / (W8_SCALE * H8_SCALE)}; pg8::gemm_phase<EpiStoreBf16, pg8::GroupedOrder, true>(F.lds, DFF, DFF, DFF, S, E); } SEAM(21);
    if (IN(22)) { PHASE_WS();
#ifdef PROBE_FIN
        _Pragma("nounroll") for (int rep = 0; rep < 3; ++rep) { p_final(F, (float*)(ws + WS_RWS)); __syncthreads(); }
#endif
        p_final(F); }
    if (PROBE_KIND && lo == 100) { PHASE_WS(); const bf16* src = (const bf16*)(ws + (size_t)PROBE_OFF); for (size_t i = (size_t)blockIdx.x * NT + F.tid; i < (size_t)MLAT * D; i += (size_t)F.G * NT) F.out[i] = bf2f(src[i]); }
#undef IN
#undef SEAM
}

extern "C" void kernel_launch(void* const* d_in, const int* in_sizes, int n_in, void* d_out, int out_size, void* d_ws, size_t ws_size, hipStream_t stream) {
    static int grid = 0;
    if (grid == 0) {
        if (n_in != 29 || out_size != MLAT * D || ws_size < WS_END) { fprintf(stderr, "kernel_launch: unexpected shapes (n_in %d out %d ws %zu)\n", n_in, out_size, ws_size); grid = -1; return; }
        int dev = 0, cus = 0;
        if (hipGetDevice(&dev) != hipSuccess || hipDeviceGetAttribute(&cus, hipDeviceAttributeMultiprocessorCount, dev) != hipSuccess) { grid = -1; return; }
        if (hipFuncSetAttribute((const void*)fwd_kernel, hipFuncAttributeMaxDynamicSharedMemorySize, LDS_BYTES) != hipSuccess) { fprintf(stderr, "kernel_launch: hipFuncSetAttribute failed\n"); grid = -1; return; }
        int per_cu = 0; (void)hipOccupancyMaxActiveBlocksPerMultiprocessor(&per_cu, (const void*)fwd_kernel, NT, LDS_BYTES); (void)hipGetLastError();
        grid = cus;
    }
    if (grid < 0) return;
    (void)hipMemsetAsync((char*)d_ws + WS_CTL, 0, CTL_ZERO_BYTES, stream);
#ifdef DEBUG_NANFILL
    (void)hipMemsetAsync((char*)d_ws + CTL_ZERO_BYTES, 0xFF, WS_END - CTL_ZERO_BYTES, stream);
#endif
    Args a{};
    for (int i = 0; i < 29; ++i) a.in[i] = (const float*)d_in[i];
    a.out = (float*)d_out; a.ws = (unsigned char*)d_ws;
#ifndef ONE_LAUNCH
    for (int p = 0; p < NPHASE && p <= STOP_AFTER; ++p) { a.ph_lo = p; a.ph_hi = p + 1; hipLaunchKernelGGL(fwd_kernel, dim3(grid), dim3(NT), LDS_BYTES, stream, a); }
    if (PROBE_KIND) { a.ph_lo = 100; a.ph_hi = 101; hipLaunchKernelGGL(fwd_kernel, dim3(grid), dim3(NT), LDS_BYTES, stream, a); }
#else
    a.ph_lo = 0; a.ph_hi = NPHASE; hipLaunchKernelGGL(fwd_kernel, dim3(grid), dim3(NT), LDS_BYTES, stream, a);
#endif
}
```
